# Optimizing an MI355X kernel written in HIP

```python
import numpy as np
import jax, jax.numpy as jnp
from jax import lax

D_MODEL = 2048
BATCH = 4
SEQ = 2048
DEPTH = 2

D_FF = 5632
EPS = 1e-6
CONV_CH = D_MODEL // 2
CONV_GROUPS = 8
CONV_WIDTH = 31
GMLP_CH = D_MODEL // 2
GMLP_GROUPS = 8
GMLP_GDIM = GMLP_CH // GMLP_GROUPS
GMLP_CHUNK = 128
HEAD_DIM = 128
N_HEADS = D_MODEL // HEAD_DIM
N_KV = 4
HPG = N_HEADS // N_KV
KV_W = N_KV * HEAD_DIM
ROT_DIM = HEAD_DIM // 4
ROPE_THETA = 500000.0
CMP_LEN = 32
CMP_STRIDE = 16
CMP_HIDDEN = 256
SEL_BLOCK = 64
SEL_TOPK = 16
WINDOW = 512
Q_BLOCK = 128
SEL_Q_CHUNK = 16
FORCE_BONUS = 1e3
NEG = -1e30
NSA_IN = D_MODEL + 6 * KV_W + 3 * N_HEADS
AB_IN = 2 * CONV_CH + 2 * GMLP_CH

kernel_name = 'hybrid_conv_gmlp_nsa_macaron'


def rmsnorm(x, g):
    xf = x.astype(jnp.float32)
    y = xf * lax.rsqrt(jnp.mean(xf * xf, axis=-1, keepdims=True) + EPS)
    return y.astype(x.dtype) * g


def layernorm(x, g, b):
    xf = x.astype(jnp.float32)
    mu = jnp.mean(xf, axis=-1, keepdims=True)
    var = jnp.mean(jnp.square(xf - mu), axis=-1, keepdims=True)
    return ((xf - mu) * lax.rsqrt(var + EPS)).astype(x.dtype) * g + b


def swiglu(h, w_gate, w_up, w_down):
    return (jax.nn.silu(h @ w_gate) * (h @ w_up)) @ w_down


def rope_tables(positions):
    inv = ROPE_THETA ** (-jnp.arange(0, ROT_DIM, 2, dtype=jnp.float32) / ROT_DIM)
    ang = positions.astype(jnp.float32)[..., None] * inv
    return jnp.cos(ang), jnp.sin(ang)


def apply_rope(x, cos, sin):
    half = ROT_DIM // 2
    cos = cos.astype(x.dtype)
    sin = sin.astype(x.dtype)
    x1, x2, rest = x[..., :half], x[..., half:ROT_DIM], x[..., ROT_DIM:]
    return jnp.concatenate([x1 * cos - x2 * sin, x2 * cos + x1 * sin, rest], axis=-1)


def conv_gmlp_mixer(h, w_in, conv_w, conv_b, conv_ln_g, conv_ln_b,
                    gmlp_ln_g, gmlp_ln_b, gmlp_ws, gmlp_bs, w_out):
    B_, S, _ = h.shape
    z = h @ w_in
    a_val, a_gate, b_u, b_v = jnp.split(z, [CONV_CH, 2 * CONV_CH, 2 * CONV_CH + GMLP_CH], axis=-1)
    a = a_val * jax.nn.sigmoid(a_gate)
    a = lax.conv_general_dilated(a, conv_w, (1,), [(CONV_WIDTH - 1, 0)],
                                 dimension_numbers=('NWC', 'WIO', 'NWC'),
                                 feature_group_count=CONV_CH) + conv_b
    a = jax.nn.silu(layernorm(a, conv_ln_g, conv_ln_b))
    nc = S // GMLP_CHUNK
    u = jax.nn.gelu(b_u).reshape(B_, nc, GMLP_CHUNK, GMLP_GROUPS, GMLP_GDIM)
    v = jax.nn.gelu(b_v).reshape(B_, nc, GMLP_CHUNK, GMLP_GROUPS, GMLP_GDIM)
    v = layernorm(v, gmlp_ln_g, gmlp_ln_b)
    tri = jnp.tril(jnp.ones((GMLP_CHUNK, GMLP_CHUNK), dtype=bool))
    ws = jnp.where(tri[None], gmlp_ws, 0.0).astype(v.dtype)
    sv = jnp.einsum('gts,bcsgd->bctgd', ws, v) + gmlp_bs.T[:, :, None]
    bo = (u * sv).reshape(B_, S, GMLP_CH)
    return jnp.concatenate([a, bo], axis=-1) @ w_out


def nsa_mixer(h, cos, sin, w_in, cmp_pe_k, cmp_w1_k, cmp_w2_k,
              cmp_pe_v, cmp_w1_v, cmp_w2_v, w_out):
    B_, S, _ = h.shape
    f32 = jnp.float32
    scale = HEAD_DIM ** -0.5
    z = h @ w_in
    offs = [D_MODEL + i * KV_W for i in range(7)]
    q, kc, vc, ks, vs, kw, vw, g = jnp.split(z, offs, axis=-1)
    q = q.reshape(B_, S, N_KV, HPG, HEAD_DIM)
    kc, vc, ks, vs, kw, vw = [t.reshape(B_, S, N_KV, HEAD_DIM) for t in (kc, vc, ks, vs, kw, vw)]
    gates = jax.nn.sigmoid(g.reshape(B_, S, N_KV, HPG, 3))
    q_r = apply_rope(q, cos[:, :, None, None], sin[:, :, None, None])
    ks_r = apply_rope(ks, cos[:, :, None], sin[:, :, None])
    kw_r = apply_rope(kw, cos[:, :, None], sin[:, :, None])
    t_np = np.arange(S)

    n_cmp = (S - CMP_LEN) // CMP_STRIDE + 1
    cidx = np.arange(n_cmp)[:, None] * CMP_STRIDE + np.arange(CMP_LEN)[None]

    def compress(k, pe, w1, w2):
        blk = k[:, cidx] + pe[:, None, :]
        blk = blk.transpose(0, 1, 3, 2, 4).reshape(B_, n_cmp, N_KV, CMP_LEN * HEAD_DIM)
        return jax.nn.gelu(blk @ w1) @ w2

    kcmp = compress(kc, cmp_pe_k, cmp_w1_k, cmp_w2_k)
    vcmp = compress(vc, cmp_pe_v, cmp_w1_v, cmp_w2_v)
    cend = cidx[:, -1]
    cmask = jnp.asarray(cend[None, :] <= t_np[:, None])
    s_c = jnp.einsum('btghd,bngd->bghtn', q, kcmp, preferred_element_type=f32) * scale
    p_c = jax.nn.softmax(jnp.where(cmask, s_c, NEG), axis=-1) * cmask
    o_c = jnp.einsum('bghtn,bngd->btghd', p_c.astype(vcmp.dtype), vcmp)

    n_blk = S // SEL_BLOCK
    n_sel = min(SEL_TOPK, n_blk)
    sb = np.arange(n_blk) * SEL_BLOCK
    overlap = (cidx[:, 0][:, None] < sb[None] + SEL_BLOCK) & (cend[:, None] >= sb[None])
    imp = jnp.einsum('bghtn,nj->btgj', p_c, jnp.asarray(overlap, f32))
    jb = np.arange(n_blk)[None]
    cur = (t_np // SEL_BLOCK)[:, None]
    forced = (jb == 0) | (jb == cur) | (jb == cur - 1)
    valid = jb * SEL_BLOCK <= t_np[:, None]
    imp = imp + FORCE_BONUS * jnp.asarray(forced, f32)[None, :, None, :]
    imp = jnp.where(jnp.asarray(valid)[None, :, None, :], imp, NEG)
    _, sel_idx = lax.top_k(imp, n_sel)

    ksb = ks_r.reshape(B_, n_blk, SEL_BLOCK, N_KV, HEAD_DIM).transpose(0, 3, 1, 2, 4)
    vsb = vs.reshape(B_, n_blk, SEL_BLOCK, N_KV, HEAD_DIM).transpose(0, 3, 1, 2, 4)
    bi = jnp.arange(B_)[:, None, None, None]
    gi = jnp.arange(N_KV)[None, None, :, None]

    def sel_chunk(args):
        qc, idx, tc = args
        kg = ksb[bi, gi, idx]
        vg = vsb[bi, gi, idx]
        kpos = idx[..., None] * SEL_BLOCK + jnp.arange(SEL_BLOCK)
        m = kpos <= tc[None, :, None, None, None]
        s = jnp.einsum('bqghd,bqgnld->bqghnl', qc, kg, preferred_element_type=f32) * scale
        s = jnp.where(m[:, :, :, None], s, NEG)
        p = jax.nn.softmax(s, axis=(-2, -1))
        return jnp.einsum('bqghnl,bqgnld->bqghd', p.astype(vg.dtype), vg)

    nq = S // SEL_Q_CHUNK
    qc_all = q_r.reshape(B_, nq, SEL_Q_CHUNK, N_KV, HPG, HEAD_DIM).transpose(1, 0, 2, 3, 4, 5)
    idx_all = sel_idx.reshape(B_, nq, SEL_Q_CHUNK, N_KV, n_sel).transpose(1, 0, 2, 3, 4)
    tc_all = jnp.arange(S, dtype=jnp.int32).reshape(nq, SEL_Q_CHUNK)
    o_s = lax.map(sel_chunk, (qc_all, idx_all, tc_all))
    o_s = o_s.transpose(1, 0, 2, 3, 4, 5).reshape(B_, S, N_KV, HPG, HEAD_DIM)

    nqb = S // Q_BLOCK
    span = WINDOW + Q_BLOCK
    widx = np.arange(nqb)[:, None] * Q_BLOCK + np.arange(span)[None]
    kpad = jnp.pad(kw_r, ((0, 0), (WINDOW, 0), (0, 0), (0, 0)))
    vpad = jnp.pad(vw, ((0, 0), (WINDOW, 0), (0, 0), (0, 0)))
    kwin = kpad[:, widx]
    vwin = vpad[:, widx]
    n_ = np.arange(nqb)[:, None, None]
    q_ = np.arange(Q_BLOCK)[None, :, None]
    k_ = np.arange(span)[None, None, :]
    kpos = n_ * Q_BLOCK + k_ - WINDOW
    qpos = n_ * Q_BLOCK + q_
    wmask = jnp.asarray((kpos <= qpos) & (kpos > qpos - WINDOW) & (kpos >= 0))
    qb = q_r.reshape(B_, nqb, Q_BLOCK, N_KV, HPG, HEAD_DIM)
    s_w = jnp.einsum('bnqghd,bnkgd->bnghqk', qb, kwin, preferred_element_type=f32) * scale
    s_w = jnp.where(wmask[None, :, None, None], s_w, NEG)
    p_w = jax.nn.softmax(s_w, axis=-1)
    o_w = jnp.einsum('bnghqk,bnkgd->bnqghd', p_w.astype(vwin.dtype), vwin)
    o_w = o_w.reshape(B_, S, N_KV, HPG, HEAD_DIM)

    o = gates[..., 0:1] * o_c + gates[..., 1:2] * o_s + gates[..., 2:3] * o_w
    return o.reshape(B_, S, D_MODEL) @ w_out


def setup_inputs(seed: int = 0) -> dict:
    key = jax.random.key(seed)
    ks = iter(jax.random.split(key, 64))
    f32 = jnp.float32

    def dense(shape, fan_in):
        return jax.random.normal(next(ks), shape, f32) * fan_in ** -0.5

    def gain(shape):
        return 1.0 + 0.02 * jax.random.normal(next(ks), shape, f32)

    def bias(shape, s=0.02):
        return s * jax.random.normal(next(ks), shape, f32)

    x = jax.random.normal(next(ks), (BATCH, SEQ, D_MODEL), f32)
    offset = jax.random.randint(next(ks), (BATCH, 1), 0, 1024, dtype=jnp.int32)
    positions = offset + jnp.arange(SEQ, dtype=jnp.int32)[None, :]

    def ffn(prefix, d):
        d[prefix + '_norm'] = gain((D_MODEL,))
        d[prefix + '_w_gate'] = dense((D_MODEL, D_FF), D_MODEL)
        d[prefix + '_w_up'] = dense((D_MODEL, D_FF), D_MODEL)
        d[prefix + '_w_down'] = dense((D_FF, D_MODEL), D_FF)

    d = {'x': x, 'positions': positions}
    ffn('l0_ffn1', d)
    d['l0_mix_norm'] = gain((D_MODEL,))
    d['l0_w_in'] = dense((D_MODEL, AB_IN), D_MODEL)
    d['l0_conv_w'] = dense((CONV_WIDTH, 1, CONV_CH), CONV_WIDTH)
    d['l0_conv_b'] = bias((CONV_CH,))
    d['l0_conv_ln_g'] = gain((CONV_CH,))
    d['l0_conv_ln_b'] = bias((CONV_CH,))
    d['l0_gmlp_ln_g'] = gain((GMLP_GROUPS, GMLP_GDIM))
    d['l0_gmlp_ln_b'] = bias((GMLP_GROUPS, GMLP_GDIM))
    d['l0_gmlp_ws'] = dense((GMLP_GROUPS, GMLP_CHUNK, GMLP_CHUNK), GMLP_CHUNK)
    d['l0_gmlp_bs'] = gain((GMLP_GROUPS, GMLP_CHUNK))
    d['l0_w_out'] = dense((CONV_CH + GMLP_CH, D_MODEL), CONV_CH + GMLP_CH)
    ffn('l0_ffn2', d)
    ffn('l1_ffn1', d)
    d['l1_mix_norm'] = gain((D_MODEL,))
    d['l1_w_in'] = dense((D_MODEL, NSA_IN), D_MODEL)
    d['l1_cmp_pe_k'] = bias((CMP_LEN, HEAD_DIM), 0.1)
    d['l1_cmp_w1_k'] = dense((CMP_LEN * HEAD_DIM, CMP_HIDDEN), CMP_LEN * HEAD_DIM)
    d['l1_cmp_w2_k'] = dense((CMP_HIDDEN, HEAD_DIM), CMP_HIDDEN)
    d['l1_cmp_pe_v'] = bias((CMP_LEN, HEAD_DIM), 0.1)
    d['l1_cmp_w1_v'] = dense((CMP_LEN * HEAD_DIM, CMP_HIDDEN), CMP_LEN * HEAD_DIM)
    d['l1_cmp_w2_v'] = dense((CMP_HIDDEN, HEAD_DIM), CMP_HIDDEN)
    d['l1_w_out'] = dense((D_MODEL, D_MODEL), D_MODEL)
    ffn('l1_ffn2', d)
    d['final_norm'] = gain((D_MODEL,))
    return d


def reference(x, positions,
              l0_ffn1_norm, l0_ffn1_w_gate, l0_ffn1_w_up, l0_ffn1_w_down,
              l0_mix_norm, l0_w_in, l0_conv_w, l0_conv_b, l0_conv_ln_g, l0_conv_ln_b,
              l0_gmlp_ln_g, l0_gmlp_ln_b, l0_gmlp_ws, l0_gmlp_bs, l0_w_out,
              l0_ffn2_norm, l0_ffn2_w_gate, l0_ffn2_w_up, l0_ffn2_w_down,
              l1_ffn1_norm, l1_ffn1_w_gate, l1_ffn1_w_up, l1_ffn1_w_down,
              l1_mix_norm, l1_w_in, l1_cmp_pe_k, l1_cmp_w1_k, l1_cmp_w2_k,
              l1_cmp_pe_v, l1_cmp_w1_v, l1_cmp_w2_v, l1_w_out,
              l1_ffn2_norm, l1_ffn2_w_gate, l1_ffn2_w_up, l1_ffn2_w_down,
              final_norm):
    cos, sin = rope_tables(positions)
    layers = (
        dict(ffn1=(l0_ffn1_norm, l0_ffn1_w_gate, l0_ffn1_w_up, l0_ffn1_w_down),
             mix_norm=l0_mix_norm,
             mix=(l0_w_in, l0_conv_w, l0_conv_b, l0_conv_ln_g, l0_conv_ln_b,
                  l0_gmlp_ln_g, l0_gmlp_ln_b, l0_gmlp_ws, l0_gmlp_bs, l0_w_out),
             ffn2=(l0_ffn2_norm, l0_ffn2_w_gate, l0_ffn2_w_up, l0_ffn2_w_down)),
        dict(ffn1=(l1_ffn1_norm, l1_ffn1_w_gate, l1_ffn1_w_up, l1_ffn1_w_down),
             mix_norm=l1_mix_norm,
             mix=(l1_w_in, l1_cmp_pe_k, l1_cmp_w1_k, l1_cmp_w2_k,
                  l1_cmp_pe_v, l1_cmp_w1_v, l1_cmp_w2_v, l1_w_out),
             ffn2=(l1_ffn2_norm, l1_ffn2_w_gate, l1_ffn2_w_up, l1_ffn2_w_down)),
    )
    for i in range(DEPTH):
        L = layers[i]
        n1, g1, u1, d1 = L['ffn1']
        x = x + 0.5 * swiglu(rmsnorm(x, n1), g1, u1, d1)
        hn = rmsnorm(x, L['mix_norm'])
        if i % 2 == 0:
            x = x + conv_gmlp_mixer(hn, *L['mix'])
        else:
            x = x + nsa_mixer(hn, cos, sin, *L['mix'])
        n2, g2, u2, d2 = L['ffn2']
        x = x + 0.5 * swiglu(rmsnorm(x, n2), g2, u2, d2)
    return rmsnorm(x, final_norm)
```

```cpp
#include <hip/hip_runtime.h>
#include <hip/hip_cooperative_groups.h>
#include <cstdio>
#include <cstring>
#include <cmath>
namespace cg = cooperative_groups;

#ifndef ONE_LAUNCH
#define ONE_LAUNCH 1
#endif

#define LAS __attribute__((address_space(3)))
#define DBG_P20 1
#ifndef DEBUG_CHECK
#define DEBUG_CHECK 0
#endif
#define DBG_DUMP 0
#define PROBE_ATT 0
#define PROBE_PRO 0
#define PROBE_UP 0
#define PROBE_SYNC 0
#define PROBE_SMALL 0
#define PROBE_PARTS 1
typedef unsigned short bf16_t;
typedef short bf16x8 __attribute__((ext_vector_type(8)));
typedef float f32x4 __attribute__((ext_vector_type(4)));
typedef float f32x2 __attribute__((ext_vector_type(2)));
typedef unsigned u32x4 __attribute__((ext_vector_type(4)));
typedef unsigned u32x2 __attribute__((ext_vector_type(2)));
typedef unsigned long long ss_t;
constexpr float SS_SCALE = 1048576.0f, SS_INV = 1.0f / 1048576.0f;

constexpr int M = 8192, D = 2048, FF = 5632, SEQ = 2048;
constexpr int ZW = 5376;
constexpr float EPS = 1e-6f;
constexpr int NPHASE = 25;
constexpr float SC_LOG2 = 0.08838834764831845f * 1.4426950408889634f;

constexpr size_t MiB = 1u << 20;
constexpr size_t WS_ROPE = 0;
constexpr size_t WS_PB = 1 * MiB;
constexpr size_t WS_CBIAS = 1 * MiB + 256 * 1024;
constexpr size_t WS_SS = 1 * MiB + 512 * 1024;
constexpr size_t WS_CNT = 1 * MiB + 992 * 1024;
constexpr size_t WS_GATE = 2 * MiB;
constexpr size_t WS_W = 4 * MiB;
constexpr size_t WS_WGU(int f) { return WS_W + (size_t)f * 66 * MiB; }
constexpr size_t WS_WD(int f) { return WS_W + (size_t)f * 66 * MiB + 44 * MiB; }
constexpr size_t WS_WIN0 = 268 * MiB, WS_WOUT0 = 284 * MiB, WS_WIN1 = 292 * MiB, WS_WOUT1 = 313 * MiB, WS_W1T = 321 * MiB;
constexpr size_t WS_X = 326 * MiB, WS_HN = 390 * MiB, WS_ACT = 422 * MiB;
constexpr size_t WS_AG = WS_ACT, WS_UV = WS_ACT + 16 * MiB, WS_MIX = WS_ACT + 48 * MiB, WS_Z = WS_ACT, WS_QR = WS_X;
constexpr size_t WS_KSR = 510 * MiB, WS_KWR = 518 * MiB, WS_KCVC = 526 * MiB, WS_VST = 543 * MiB, WS_VWT = 551 * MiB;
constexpr size_t WS_H1 = 559 * MiB, WS_KCMP = 561 * MiB, WS_VCMPT = 562 * MiB, WS_END = 563 * MiB;
constexpr size_t WS_OACC = WS_W;
constexpr size_t WS_OB = WS_W + 66 * MiB;
constexpr size_t WS_H1P = WS_W + 132 * MiB;

constexpr int LDS_BYTES = 147456;

struct TDesc { const float* W; bf16_t* WT; const float* gain; int K, ldw, col0, nvalid, nblk, mode; };
constexpr int NDESC = 20;
struct Params {
    const float* in[39];
    const int* positions;
    float* out;
    unsigned char* ws;
    TDesc td[NDESC];
    int tstart[NDESC + 4];
    double inv_freq[16];
    int ph_lo, ph_hi;
};

__device__ __forceinline__ float bflo(unsigned w) { return __uint_as_float(w << 16); }
__device__ __forceinline__ float bfhi(unsigned w) { return __uint_as_float(w & 0xffff0000u); }
__device__ __forceinline__ float bf1(bf16_t b) { return __uint_as_float(((unsigned)b) << 16); }
typedef __bf16 bf16x2_t __attribute__((ext_vector_type(2)));
__device__ __forceinline__ unsigned cvt_pk_bf16(float lo, float hi) { const f32x2 v = {lo, hi}; return __builtin_bit_cast(unsigned, __builtin_convertvector(v, bf16x2_t)); }
__device__ __forceinline__ float sigmoid_f(float x) { return __builtin_amdgcn_rcpf(1.0f + __builtin_amdgcn_exp2f(-1.44269504f * x)); }
__device__ __forceinline__ float silu_f(float x) { return x * sigmoid_f(x); }
__device__ __forceinline__ float gelu_f(float x) { const float u = 1.5957691216f * (x + 0.044715f * x * x * x); return x * sigmoid_f(u); }
__device__ __forceinline__ float wave_sum(float v) {
#pragma unroll
    for (int o = 1; o < 64; o <<= 1) v += __shfl_xor(v, o);
    return v;
}
#define LDS_WAIT() asm volatile("s_waitcnt lgkmcnt(0)" ::: "memory")

namespace pg8 {
constexpr int BM = 256, BK = 64, HALF = 128, HTB = HALF * BK * 2, STAGE_BYTES = 8 * HTB, NXCD = 8, WGM = 8;
__device__ __forceinline__ int lds_byte(int r, int c) { const int st = (r >> 4) * 2 + (c >> 5), rr = r & 15, cc = c & 31, ob = rr * 64 + cc * 2; return st * 1024 + (ob ^ (((ob >> 9) & 1) << 5)); }
__device__ __forceinline__ void stage_rc(int b, int& R, int& C) { const int st = b / 1024, sb = b % 1024, swz = sb ^ (((sb >> 9) & 1) << 5); R = (st >> 1) * 16 + swz / 64; C = (st & 1) * 32 + (swz % 64) / 2; }
__device__ __forceinline__ int perm32(int rho) { const int n = rho >> 4, i = rho & 15; return 8 * (i >> 2) + 4 * n + (i & 3); }

struct Unit { int pm, pn, koff; };
struct Gemm { const bf16_t* A; const bf16_t* Bt; int M, N, K, lda, ldb; };

struct StaticOrder {
    int nM, nN, nwg, G, c;
    __device__ void init(int M_, int N_, int G_, int c_) { nM = M_ / BM; nN = N_ / BM; nwg = nM * nN; G = G_; c = c_; }
    __device__ bool next(int i, Unit& u) const {
        const long L = (long)i * G + c; if (L >= nwg) return false;
        int wgid = (int)L; { const int q = nwg / NXCD, r = nwg % NXCD, xcd = wgid % NXCD, off = wgid / NXCD; wgid = (xcd < r ? xcd * (q + 1) : r * (q + 1) + (xcd - r) * q) + off; }
        const int nig = WGM * nN, gid = wgid / nig, fm = gid * WGM, gsz = (nM - fm) < WGM ? (nM - fm) : WGM;
        u.pm = fm + ((wgid % nig) % gsz); u.pn = (wgid % nig) / gsz; u.koff = 0; return true;
    }
};
struct CmpOrder {
    int G, c;
    __device__ bool next(int i, Unit& u) const { const int L = i * G + c; if (L >= 128) return false; u.pm = L & 15; u.pn = (L & 15) >> 3; u.koff = (L >> 4) * 1024; return true; }
};

struct EpiSwiGLU {
    static constexpr bool PERM = true, AFTER_DRAIN = false;
    bf16_t* O; const ss_t* ss;
    __device__ __forceinline__ void operator()(const f32x4 (&acc)[2][2][4][2], const Unit& u, int wr, int wc, int fr, int fq) const {
        const int row0 = u.pm * BM + wr * 64 + fr, col0 = u.pn * 128 + wc * 32 + 8 * fq;
        float rs[8];
#pragma unroll
        for (int q = 0; q < 8; ++q) rs[q] = (float)ss[row0 + (q >> 2) * HALF + (q & 3) * 16] * SS_INV;
#pragma unroll
        for (int q = 0; q < 8; ++q) rs[q] = rsqrtf(rs[q] * (1.0f / D) + EPS);
#pragma unroll
        for (int ai = 0; ai < 2; ++ai)
#pragma unroll
            for (int m = 0; m < 4; ++m) {
                const int row = row0 + ai * HALF + m * 16;
                const float rstd = rs[ai * 4 + m], rl = -1.44269504f * rstd, r2 = rstd * rstd;
                bf16_t* rowp = O + (size_t)row * FF + col0;
                unsigned pk[4];
#pragma unroll
                for (int n = 0; n < 2; ++n)
#pragma unroll
                    for (int h2 = 0; h2 < 2; ++h2) {
                        const f32x2 g = {acc[ai][0][m][n][2 * h2], acc[ai][0][m][n][2 * h2 + 1]}, u = {acc[ai][1][m][n][2 * h2], acc[ai][1][m][n][2 * h2 + 1]};
                        const f32x2 t = g * rl;
                        f32x2 e; e.x = __builtin_amdgcn_exp2f(t.x); e.y = __builtin_amdgcn_exp2f(t.y);
                        const f32x2 d = e + 1.0f;
                        f32x2 sg; sg.x = __builtin_amdgcn_rcpf(d.x); sg.y = __builtin_amdgcn_rcpf(d.y);
                        const f32x2 o = (g * u) * (sg * r2);
                        pk[n * 2 + h2] = cvt_pk_bf16(o.x, o.y);
                    }
                u32x4 w; w.x = pk[0]; w.y = pk[1]; w.z = pk[2]; w.w = pk[3];
                *(u32x4*)rowp = w;
            }
    }
};
template <bool HALFA, bool BASEF32>
struct EpiResid {
    static constexpr bool PERM = false, AFTER_DRAIN = false;
    const float* basef; bf16_t* xb; ss_t* ss;
    __device__ __forceinline__ void operator()(const f32x4 (&acc)[2][2][4][2], const Unit& u, int wr, int wc, int fr, int fq) const {
        const float alpha = HALFA ? 0.5f : 1.0f;
        const int row0 = u.pm * BM + wr * 64 + fr, col0 = u.pn * BM + wc * 32 + 4 * fq;
        float sq[8];
#pragma unroll
        for (int ai = 0; ai < 2; ++ai) {
            f32x4 b[4][2][2];
#pragma unroll
            for (int m = 0; m < 4; ++m)
#pragma unroll
                for (int bj = 0; bj < 2; ++bj)
#pragma unroll
                    for (int n = 0; n < 2; ++n) {
                        const size_t o = (size_t)(row0 + ai * HALF + m * 16) * D + col0 + bj * HALF + n * 16;
                        if (BASEF32) b[m][bj][n] = *(const f32x4*)(basef + o);
                        else { const u32x2 w = *(const u32x2*)(xb + o); b[m][bj][n] = (f32x4){bflo(w.x), bfhi(w.x), bflo(w.y), bfhi(w.y)}; }
                    }
#pragma unroll
            for (int m = 0; m < 4; ++m) {
                const size_t off = (size_t)(row0 + ai * HALF + m * 16) * D + col0;
                float q = 0.f;
#pragma unroll
                for (int bj = 0; bj < 2; ++bj)
#pragma unroll
                    for (int n = 0; n < 2; ++n) { const f32x4 v = b[m][bj][n] + alpha * acc[ai][bj][m][n];
                        u32x2 w; w.x = cvt_pk_bf16(v[0], v[1]); w.y = cvt_pk_bf16(v[2], v[3]); *(u32x2*)(xb + off + bj * HALF + n * 16) = w;
                        q += (v[0] * v[0] + v[1] * v[1]) + (v[2] * v[2] + v[3] * v[3]); }
                sq[ai * 4 + m] = q;
            }
        }
#pragma unroll
        for (int q = 0; q < 8; ++q) { float t = sq[q]; t += __shfl_xor(t, 16); t += __shfl_xor(t, 32); sq[q] = t; }
        if (fq == 0) {
#pragma unroll
            for (int q = 0; q < 8; ++q) __hip_atomic_fetch_add(ss + row0 + (q >> 2) * HALF + (q & 3) * 16, (ss_t)(sq[q] * SS_SCALE), __ATOMIC_RELAXED, __HIP_MEMORY_SCOPE_AGENT);
        }
    }
};
struct EpiResidFinal {
    static constexpr bool PERM = false, AFTER_DRAIN = true;
    const bf16_t* xb; ss_t* ss; unsigned* cnt; const float* gain; float* out;
    __device__ __forceinline__ void fused(f32x4 (&acc)[2][2][4][2], const Unit& u, int wr, int wc, int fr, int fq, int tid) const {
        const int row0 = u.pm * BM + wr * 64 + fr, col0 = u.pn * BM + wc * 32 + 4 * fq;
        float sq[8];
#pragma unroll
        for (int ai = 0; ai < 2; ++ai) {
            u32x2 b[4][2][2];
#pragma unroll
            for (int m = 0; m < 4; ++m)
#pragma unroll
                for (int bj = 0; bj < 2; ++bj)
#pragma unroll
                    for (int n = 0; n < 2; ++n) b[m][bj][n] = *(const u32x2*)(xb + (size_t)(row0 + ai * HALF + m * 16) * D + col0 + bj * HALF + n * 16);
#pragma unroll
            for (int m = 0; m < 4; ++m) {
                float q = 0.f;
#pragma unroll
                for (int bj = 0; bj < 2; ++bj)
#pragma unroll
                    for (int n = 0; n < 2; ++n) { const u32x2 w = b[m][bj][n]; const f32x4 v = (f32x4){bflo(w.x), bfhi(w.x), bflo(w.y), bfhi(w.y)} + 0.5f * acc[ai][bj][m][n];
                        acc[ai][bj][m][n] = v; q += (v[0] * v[0] + v[1] * v[1]) + (v[2] * v[2] + v[3] * v[3]); }
                sq[ai * 4 + m] = q;
            }
        }
#pragma unroll
        for (int q = 0; q < 8; ++q) { float t = sq[q]; t += __shfl_xor(t, 16); t += __shfl_xor(t, 32); sq[q] = t; }
        if (fq == 0) {
#pragma unroll
            for (int q = 0; q < 8; ++q) __hip_atomic_fetch_add(ss + row0 + (q >> 2) * HALF + (q & 3) * 16, (ss_t)(sq[q] * SS_SCALE), __ATOMIC_RELAXED, __HIP_MEMORY_SCOPE_AGENT);
        }
        asm volatile("s_waitcnt vmcnt(0)" ::: "memory");
        __syncthreads();
        if (tid == 0) {
            unsigned* c = cnt + 64 * u.pm;
            __hip_atomic_fetch_add(c, 1u, __ATOMIC_RELAXED, __HIP_MEMORY_SCOPE_AGENT);
            unsigned spins = 0;
            while (__hip_atomic_load(c, __ATOMIC_RELAXED, __HIP_MEMORY_SCOPE_AGENT) < 8u) { __builtin_amdgcn_s_sleep(1); if (++spins > (1u << 22)) break; }
            __builtin_amdgcn_fence(__ATOMIC_ACQUIRE, "agent");
            asm volatile("s_waitcnt vmcnt(0)" ::: "memory");
        }
        __syncthreads();
        float rs[8];
#pragma unroll
        for (int q = 0; q < 8; ++q) rs[q] = (float)__hip_atomic_load(ss + row0 + (q >> 2) * HALF + (q & 3) * 16, __ATOMIC_RELAXED, __HIP_MEMORY_SCOPE_AGENT) * SS_INV;
#pragma unroll
        for (int q = 0; q < 8; ++q) rs[q] = 1.0f / sqrtf(rs[q] * (1.0f / D) + EPS);
        f32x4 gg[2][2];
#pragma unroll
        for (int bj = 0; bj < 2; ++bj)
#pragma unroll
            for (int n = 0; n < 2; ++n) gg[bj][n] = *(const f32x4*)(gain + col0 + bj * HALF + n * 16);
#pragma unroll
        for (int ai = 0; ai < 2; ++ai)
#pragma unroll
            for (int m = 0; m < 4; ++m) {
                const float rstd = rs[ai * 4 + m];
                float* op = out + (size_t)(row0 + ai * HALF + m * 16) * D + col0;
#pragma unroll
                for (int bj = 0; bj < 2; ++bj)
#pragma unroll
                    for (int n = 0; n < 2; ++n) *(f32x4*)(op + bj * HALF + n * 16) = acc[ai][bj][m][n] * rstd * gg[bj][n];
            }
    }
};
struct EpiL0In {
    static constexpr bool PERM = true, AFTER_DRAIN = false;
    bf16_t* AG; bf16_t* UV; const ss_t* ss;
    __device__ __forceinline__ void operator()(const f32x4 (&acc)[2][2][4][2], const Unit& u, int wr, int wc, int fr, int fq) const {
        const int row0 = u.pm * BM + wr * 64 + fr;
        float rs[8];
#pragma unroll
        for (int q = 0; q < 8; ++q) rs[q] = (float)ss[row0 + (q >> 2) * HALF + (q & 3) * 16] * SS_INV;
#pragma unroll
        for (int q = 0; q < 8; ++q) rs[q] = rsqrtf(rs[q] * (1.0f / D) + EPS);
        if (u.pn < 8) {
            const int col0 = u.pn * 128 + wc * 32 + 8 * fq;
#pragma unroll
            for (int ai = 0; ai < 2; ++ai)
#pragma unroll
                for (int m = 0; m < 4; ++m) {
                    const float rstd = rs[ai * 4 + m];
                    float v[8];
#pragma unroll
                    for (int n = 0; n < 2; ++n)
#pragma unroll
                        for (int i = 0; i < 4; ++i) v[n * 4 + i] = (acc[ai][0][m][n][i] * rstd) * sigmoid_f(acc[ai][1][m][n][i] * rstd);
                    u32x4 w; w.x = cvt_pk_bf16(v[0], v[1]); w.y = cvt_pk_bf16(v[2], v[3]); w.z = cvt_pk_bf16(v[4], v[5]); w.w = cvt_pk_bf16(v[6], v[7]);
                    *(u32x4*)(AG + (size_t)(row0 + ai * HALF + m * 16) * 1024 + col0) = w;
                }
        } else {
            const int col0 = (u.pn - 8) * BM + wc * 32 + 8 * fq;
#pragma unroll
            for (int ai = 0; ai < 2; ++ai)
#pragma unroll
                for (int m = 0; m < 4; ++m)
#pragma unroll
                    for (int bj = 0; bj < 2; ++bj) {
                        const float rstd = rs[ai * 4 + m];
                        float v[8];
#pragma unroll
                        for (int n = 0; n < 2; ++n)
#pragma unroll
                            for (int i = 0; i < 4; ++i) v[n * 4 + i] = gelu_f(acc[ai][bj][m][n][i] * rstd);
                        u32x4 w; w.x = cvt_pk_bf16(v[0], v[1]); w.y = cvt_pk_bf16(v[2], v[3]); w.z = cvt_pk_bf16(v[4], v[5]); w.w = cvt_pk_bf16(v[6], v[7]);
                        *(u32x4*)(UV + (size_t)(row0 + ai * HALF + m * 16) * 2048 + col0 + bj * HALF) = w;
                    }
        }
    }
};
struct EpiBf16 {
    static constexpr bool PERM = true, AFTER_DRAIN = false;
    bf16_t* O; int ldc; const ss_t* ss; bf16_t* kcvc;
    __device__ __forceinline__ void operator()(const f32x4 (&acc)[2][2][4][2], const Unit& u, int wr, int wc, int fr, int fq) const {
        const int row0 = u.pm * BM + wr * 64 + fr, col0 = u.pn * BM + wc * 32 + 8 * fq;
        const bool tokv = kcvc != nullptr && u.pn >= 8 && u.pn < 12;
        float rs[8];
#pragma unroll
        for (int q = 0; q < 8; ++q) rs[q] = (float)ss[row0 + (q >> 2) * HALF + (q & 3) * 16] * SS_INV;
#pragma unroll
        for (int q = 0; q < 8; ++q) rs[q] = rsqrtf(rs[q] * (1.0f / D) + EPS);
#pragma unroll
        for (int ai = 0; ai < 2; ++ai)
#pragma unroll
            for (int m = 0; m < 4; ++m)
#pragma unroll
                for (int bj = 0; bj < 2; ++bj) {
                    const float rstd = rs[ai * 4 + m];
                    const f32x4 v0 = acc[ai][bj][m][0] * rstd, v1 = acc[ai][bj][m][1] * rstd;
                    u32x4 w; w.x = cvt_pk_bf16(v0[0], v0[1]); w.y = cvt_pk_bf16(v0[2], v0[3]); w.z = cvt_pk_bf16(v1[0], v1[1]); w.w = cvt_pk_bf16(v1[2], v1[3]);
                    const int row = row0 + ai * HALF + m * 16;
                    if (tokv) { const int which = (u.pn - 8) >> 1, g = 2 * ((u.pn - 8) & 1) + bj, b = row >> 11, t = row & (SEQ - 1);
                        *(u32x4*)(kcvc + (size_t)which * 16 * SEQ * 128 + ((size_t)(b * 4 + g) * SEQ + t) * 128 + wc * 32 + 8 * fq) = w; }
                    else *(u32x4*)(O + (size_t)row * ldc + col0 + bj * HALF) = w;
                }
    }
};
struct EpiCmp {
    static constexpr bool PERM = false, AFTER_DRAIN = false;
    float* P;
    __device__ __forceinline__ void operator()(const f32x4 (&acc)[2][2][4][2], const Unit& u, int wr, int wc, int fr, int fq) const {
        const int row0 = u.pm * BM + wr * 64 + fr, col0 = wc * 32 + 4 * fq;
        float* base = P + (size_t)(u.koff >> 10) * 4096 * 256;
#pragma unroll
        for (int ai = 0; ai < 2; ++ai)
#pragma unroll
            for (int m = 0; m < 4; ++m)
#pragma unroll
                for (int bj = 0; bj < 2; ++bj)
#pragma unroll
                    for (int n = 0; n < 2; ++n) *(f32x4*)(base + (size_t)(row0 + ai * HALF + m * 16) * 256 + col0 + bj * HALF + n * 16) = acc[ai][bj][m][n];
    }
};

template <class Epi, class Sched>
__device__ __forceinline__ void gemm_phase(LAS unsigned char* lds, const Gemm g, const Sched& S, const Epi& E, const int tid) {
    const int wid = __builtin_amdgcn_readfirstlane(tid >> 6), lane = tid & 63, wr = wid >> 2, wc = wid & 3, fr = lane & 15, fq = lane >> 4;
    const int K = g.K, nt = K / BK, lda = g.lda, ldb = g.ldb;
    unsigned voffA[2], voffB[2];
#pragma unroll
    for (int i = 0; i < 2; ++i) { int R, C; stage_rc(tid * 16 + i * 8192, R, C); const int Rb = Epi::PERM ? ((R & ~31) + perm32(R & 31)) : R;
        voffA[i] = (unsigned)(R * lda + C) * 2u; voffB[i] = (unsigned)(Rb * ldb + C) * 2u; }
    const size_t kstep = (size_t)(BK * 2);
    const size_t hstepA = (size_t)HALF * lda * 2, hstepB = (size_t)HALF * ldb * 2;
    const size_t tstepA = 2 * hstepA, tstepB = 2 * hstepB;
    const unsigned ldsw = (unsigned)wid * 1024u;
    const int aoff = lds_byte(wr * 64 + fr, fq * 8), boff = lds_byte(wc * 32 + fr, fq * 8);
#define PG8_SA(b, h) (((b) * 2 + (h)) * HTB)
#define PG8_SB(b, h) ((4 + (b) * 2 + (h)) * HTB)
#define PG8_STAGE(bufoff, gbase, voff) do { _Pragma("unroll") for (int _i = 0; _i < 2; ++_i) \
        __builtin_amdgcn_global_load_lds((const unsigned*)((const char*)(gbase) + (voff)[_i]), (LAS unsigned*)(lds + (bufoff) + ldsw + _i * 8192), 16, 0, 0); } while (0)
#define PG8_LDA(dst, b, h) do { _Pragma("unroll") for (int m = 0; m < 4; ++m) _Pragma("unroll") for (int k = 0; k < 2; ++k) dst[m][k] = *(const LAS bf16x8*)(lds + PG8_SA(b, h) + aoff + m * 2048 + k * 1024); } while (0)
#define PG8_LDB(dst, b, h) do { _Pragma("unroll") for (int n = 0; n < 2; ++n) _Pragma("unroll") for (int k = 0; k < 2; ++k) dst[n][k] = *(const LAS bf16x8*)(lds + PG8_SB(b, h) + boff + n * 2048 + k * 1024); } while (0)
#define PG8_MMA(ai, bj, At, Bt) do { __builtin_amdgcn_s_setprio(1); _Pragma("unroll") for (int m = 0; m < 4; ++m) _Pragma("unroll") for (int n = 0; n < 2; ++n) _Pragma("unroll") for (int k = 0; k < 2; ++k) \
        acc[ai][bj][m][n] = __builtin_amdgcn_mfma_f32_16x16x32_bf16(Bt[n][k], At[m][k], acc[ai][bj][m][n], 0, 0, 0); __builtin_amdgcn_s_setprio(0); } while (0)
#define PG8_WAIT_V(n) asm volatile("s_waitcnt vmcnt(" #n ")" ::: "memory")
#define PG8_WAIT_L(n) asm volatile("s_waitcnt lgkmcnt(" #n ")" ::: "memory")
#define PG8_BAR __builtin_amdgcn_s_barrier()
#define PG8_SCHED __builtin_amdgcn_sched_barrier(0)
    Unit cur, nxt; int ui = 0;
    if (!S.next(0, cur)) return;
    f32x4 acc[2][2][4][2];
#pragma unroll
    for (int a = 0; a < 2; ++a)
#pragma unroll
        for (int b = 0; b < 2; ++b)
#pragma unroll
            for (int m = 0; m < 4; ++m)
#pragma unroll
                for (int n = 0; n < 2; ++n) acc[a][b][m][n] = (f32x4){0.f, 0.f, 0.f, 0.f};
    bf16x8 At[4][2], B0[2][2], B1[2][2];
    const char* cA = (const char*)g.A + (size_t)cur.pm * tstepA + cur.koff; const char* cB = (const char*)g.Bt + (size_t)cur.pn * tstepB + cur.koff;
    PG8_STAGE(PG8_SB(0, 0), cB, voffB); PG8_STAGE(PG8_SA(0, 0), cA, voffA); PG8_STAGE(PG8_SB(0, 1), cB + hstepB, voffB); PG8_STAGE(PG8_SA(0, 1), cA + hstepA, voffA);
    if (wr == 1) PG8_BAR;
    PG8_WAIT_V(4); PG8_BAR;
    PG8_STAGE(PG8_SB(1, 0), cB + kstep, voffB); PG8_STAGE(PG8_SA(1, 0), cA + kstep, voffA); PG8_STAGE(PG8_SB(1, 1), cB + hstepB + kstep, voffB);
    PG8_WAIT_V(6); PG8_BAR;
    for (;;) {
        const bool has_next = S.next(ui + 1, nxt);
        const char* nA = has_next ? (const char*)g.A + (size_t)nxt.pm * tstepA + nxt.koff : cA; const char* nB = has_next ? (const char*)g.Bt + (size_t)nxt.pn * tstepB + nxt.koff : cB;
        for (int t = 0; t < nt; t += 2) {
            const bool last = (t == nt - 2);
            const char* a1 = cA + (size_t)(t + 1) * kstep;
            const char* a2 = last ? nA : cA + (size_t)(t + 2) * kstep; const char* b2 = last ? nB : cB + (size_t)(t + 2) * kstep;
            const char* a3 = a2 + kstep; const char* b3 = b2 + kstep;
            PG8_LDB(B0, 0, 0); PG8_SCHED; PG8_LDA(At, 0, 0); PG8_STAGE(PG8_SA(1, 1), a1 + hstepA, voffA);
            PG8_WAIT_L(8); PG8_BAR; PG8_WAIT_L(0); PG8_MMA(0, 0, At, B0); PG8_BAR; PG8_SCHED;
            PG8_LDB(B1, 0, 1); PG8_STAGE(PG8_SB(0, 0), b2, voffB);
            PG8_BAR; PG8_WAIT_L(0); PG8_MMA(0, 1, At, B1); PG8_BAR;
            PG8_LDA(At, 0, 1); PG8_STAGE(PG8_SA(0, 0), a2, voffA);
            PG8_BAR; PG8_WAIT_L(0); PG8_MMA(1, 0, At, B0); PG8_BAR; PG8_SCHED;
            PG8_STAGE(PG8_SB(0, 1), b2 + hstepB, voffB);
            PG8_WAIT_V(6); PG8_BAR; PG8_MMA(1, 1, At, B1); PG8_BAR;
            PG8_LDB(B0, 1, 0); PG8_SCHED; PG8_LDA(At, 1, 0); PG8_STAGE(PG8_SA(0, 1), a2 + hstepA, voffA);
            PG8_WAIT_L(8); PG8_BAR; PG8_WAIT_L(0); PG8_MMA(0, 0, At, B0); PG8_BAR; PG8_SCHED;
            PG8_LDB(B1, 1, 1); PG8_STAGE(PG8_SB(1, 0), b3, voffB);
            PG8_BAR; PG8_WAIT_L(0); PG8_MMA(0, 1, At, B1); PG8_BAR;
            PG8_LDA(At, 1, 1); PG8_STAGE(PG8_SA(1, 0), a3, voffA);
            PG8_BAR; PG8_WAIT_L(0); PG8_MMA(1, 0, At, B0); PG8_BAR; PG8_SCHED;
            PG8_STAGE(PG8_SB(1, 1), b3 + hstepB, voffB);
            PG8_WAIT_V(6); PG8_BAR; PG8_MMA(1, 1, At, B1); PG8_BAR;
        }
        if constexpr (!Epi::AFTER_DRAIN) E(acc, cur, wr, wc, fr, fq);
        if (!has_next) break;
#pragma unroll
        for (int a = 0; a < 2; ++a)
#pragma unroll
            for (int b = 0; b < 2; ++b)
#pragma unroll
                for (int m = 0; m < 4; ++m)
#pragma unroll
                    for (int n = 0; n < 2; ++n) acc[a][b][m][n] = (f32x4){0.f, 0.f, 0.f, 0.f};
        cur = nxt; cA = nA; cB = nB; ++ui;
    }
    PG8_WAIT_V(0);
    if (wr == 0) PG8_BAR;
    PG8_BAR;
    if constexpr (Epi::AFTER_DRAIN) E.fused(acc, cur, wr, wc, fr, fq, tid);
#undef PG8_SA
#undef PG8_SB
#undef PG8_STAGE
#undef PG8_LDA
#undef PG8_LDB
#undef PG8_MMA
#undef PG8_WAIT_V
#undef PG8_WAIT_L
#undef PG8_BAR
#undef PG8_SCHED
}
}

__device__ __forceinline__ void transpose_item(const float* W, bf16_t* WT, const float* gain, int K, int ldw, int col0, int nvalid, int nblk, int mode, int item, int lane) {
    const int kb = item / nblk, nb = item - kb * nblk, k0 = 64 * kb, n0 = 64 * nb;
    const bool ok = (n0 + lane) < nvalid;
    const float* rowbase = W + (size_t)k0 * ldw + col0 + n0;
    const unsigned loff = ok ? (unsigned)lane : 0u;
    float v[64];
#pragma unroll
    for (int i = 0; i < 64; ++i) v[i] = __builtin_nontemporal_load(rowbase + (size_t)i * ldw + loff);
    if (gain) {
#pragma unroll
        for (int i = 0; i < 64; ++i) v[i] *= gain[k0 + i];
    }
    const int drow = ((mode == 0) ? n0 : (256 * (n0 >> 7) + (n0 & 127) + (mode == 2 ? 128 : 0))) + lane;
    u32x4* dst = (u32x4*)(WT + (size_t)drow * K + k0);
#pragma unroll
    for (int c = 0; c < 8; ++c) {
        u32x4 o; o.x = cvt_pk_bf16(v[8 * c + 0], v[8 * c + 1]); o.y = cvt_pk_bf16(v[8 * c + 2], v[8 * c + 3]); o.z = cvt_pk_bf16(v[8 * c + 4], v[8 * c + 5]); o.w = cvt_pk_bf16(v[8 * c + 6], v[8 * c + 7]);
        if (!ok) o = (u32x4){0u, 0u, 0u, 0u};
        dst[c] = o;
    }
}

__device__ __forceinline__ void convert_range(const Params& p, int lo, int hi, int widx, int nw, int lane) {
    int d = 0;
    for (int it = lo + widx; it < hi; it += nw) {
        while (it >= p.tstart[d + 1]) ++d;
        const float* W = p.td[d].W; bf16_t* WT = p.td[d].WT; const float* gain = p.td[d].gain; const int K = p.td[d].K, ldw = p.td[d].ldw, col0 = p.td[d].col0, nvalid = p.td[d].nvalid, nblk = p.td[d].nblk, mode = p.td[d].mode;
        transpose_item(W, WT, gain, K, ldw, col0, nvalid, nblk, mode, it - p.tstart[d], lane);
    }
}
__device__ __forceinline__ void prologue_phase(const Params& p, LAS unsigned char* lds, int tid, int wave, int lane) {
    const int gw = blockIdx.x * 8 + wave, NGW = gridDim.x * 8;
    {
        const int n1 = p.tstart[2], base2 = p.tstart[12], total = n1 + (p.tstart[16] - base2);
        int d = 0;
        for (int v = gw; v < total; v += NGW) {
            const int it = (v < n1) ? v : (v - n1 + base2);
            while (it >= p.tstart[d + 1]) ++d;
            const float* W = p.td[d].W; bf16_t* WT = p.td[d].WT; const float* gain = p.td[d].gain; const int K = p.td[d].K, ldw = p.td[d].ldw, col0 = p.td[d].col0, nvalid = p.td[d].nvalid, nblk = p.td[d].nblk, mode = p.td[d].mode;
            transpose_item(W, WT, gain, K, ldw, col0, nvalid, nblk, mode, it - p.tstart[d], lane);
        }
    }
    {
        ss_t* SS = (ss_t*)(p.ws + WS_SS); bf16_t* XB = (bf16_t*)(p.ws + WS_HN); const float* xin = p.in[0];
        for (int m = gw; m < M; m += NGW) {
            const f32x4* xr = (const f32x4*)(xin + (size_t)m * D) + lane; u32x2* o = (u32x2*)(XB + (size_t)m * D) + lane; float sq = 0.f;
#pragma unroll
            for (int j = 0; j < 8; ++j) { const f32x4 v = xr[64 * j]; sq += (v.x * v.x + v.y * v.y) + (v.z * v.z + v.w * v.w); u32x2 w; w.x = cvt_pk_bf16(v.x, v.y); w.y = cvt_pk_bf16(v.z, v.w); o[64 * j] = w; }
            sq = wave_sum(sq);
            if (lane == 0) SS[m] = (ss_t)(sq * SS_SCALE);
        }
        for (int idx = blockIdx.x * 512 + tid; idx < 6 * M; idx += gridDim.x * 512) SS[M + idx] = 0ull;
        if (blockIdx.x == 0 && tid < 32) ((unsigned*)(p.ws + WS_CNT))[64 * tid] = 0u;
        if (blockIdx.x == 1) { u32x4* pad = (u32x4*)(p.ws + WS_KCVC + (size_t)2 * 16 * SEQ * 128 * 2); for (int i = tid; i < 1024; i += 512) pad[i] = (u32x4){0u, 0u, 0u, 0u}; }
    }
    {
        f32x2* rope = (f32x2*)(p.ws + WS_ROPE);
        const int gt = blockIdx.x * 512 + tid, NT = gridDim.x * 512;
        for (int idx = gt; idx < M * 16; idx += NT) {
            const int m = idx >> 4, i = idx & 15;
            const double ang = (double)p.positions[m] * p.inv_freq[i];
            double rev = ang * 0.15915494309189535; rev -= floor(rev);
            const float rf = (float)rev;
            rope[idx] = (f32x2){__builtin_amdgcn_cosf(rf), __builtin_amdgcn_sinf(rf)};
        }
    }
    {
        float* PB = (float*)(p.ws + WS_PB);
        for (int it = gw; it < 512; it += NGW) {
            const int kv = it >> 8, cg4 = (it >> 6) & 3, kc = it & 63;
            const float* pe = p.in[kv ? 30 : 27]; const float* w1 = p.in[kv ? 31 : 28];
            float s = 0.f;
            for (int kk = 0; kk < 64; ++kk) s += pe[64 * kc + kk] * w1[(size_t)(64 * kc + kk) * 256 + 64 * cg4 + lane];
            PB[(kv * 64 + kc) * 256 + 64 * cg4 + lane] = s;
        }
    }
}

__device__ __forceinline__ void norm_phase(const float* X, const float* g, bf16_t* HN, int wave, int lane) {
    const int gw = blockIdx.x * 8 + wave, NGW = gridDim.x * 8;
    for (int m = gw; m < M; m += NGW) {
        const f32x4* xr = (const f32x4*)(X + (size_t)m * D) + lane;
        f32x4 v[8]; float s = 0.f;
#pragma unroll
        for (int j = 0; j < 8; ++j) { v[j] = xr[64 * j]; s += (v[j].x * v[j].x + v[j].y * v[j].y) + (v[j].z * v[j].z + v[j].w * v[j].w); }
        const float rstd = 1.0f / sqrtf(wave_sum(s) * (1.0f / D) + EPS);
        u32x2* o = (u32x2*)(HN + (size_t)m * D) + lane;
#pragma unroll
        for (int j = 0; j < 8; ++j) { const f32x4 gg = ((const f32x4*)g)[lane + 64 * j]; u32x2 w; w.x = cvt_pk_bf16(v[j].x * rstd * gg.x, v[j].y * rstd * gg.y); w.y = cvt_pk_bf16(v[j].z * rstd * gg.z, v[j].w * rstd * gg.w); o[64 * j] = w; }
    }
}
__device__ __forceinline__ void final_norm_phase(const bf16_t* XB, const float* g, float* out, int wave, int lane) {
    const int gw = blockIdx.x * 8 + wave, NGW = gridDim.x * 8;
    for (int m = gw; m < M; m += NGW) {
        const u32x2* xr = (const u32x2*)(XB + (size_t)m * D) + lane;
        f32x4 v[8]; float s = 0.f;
#pragma unroll
        for (int j = 0; j < 8; ++j) { const u32x2 w = xr[64 * j]; v[j] = (f32x4){bflo(w.x), bfhi(w.x), bflo(w.y), bfhi(w.y)}; s += (v[j].x * v[j].x + v[j].y * v[j].y) + (v[j].z * v[j].z + v[j].w * v[j].w); }
        const float rstd = 1.0f / sqrtf(wave_sum(s) * (1.0f / D) + EPS);
        f32x4* o = (f32x4*)(out + (size_t)m * D) + lane;
#pragma unroll
        for (int j = 0; j < 8; ++j) { const f32x4 gg = ((const f32x4*)g)[lane + 64 * j]; o[64 * j] = v[j] * rstd * gg; }
    }
}

__device__ __forceinline__ void conv_gmlp_phase(const Params& p, LAS unsigned char* lds, int tid, int wave, int lane, const int parts = 3) {
    const bf16_t* AG = (const bf16_t*)(p.ws + WS_AG); const bf16_t* UV = (const bf16_t*)(p.ws + WS_UV); bf16_t* MIX = (bf16_t*)(p.ws + WS_MIX);
    const float* conv_w = p.in[8]; const float* conv_b = p.in[9]; const float* cg_ = p.in[10]; const float* cb_ = p.in[11];
    const float* lg = p.in[12]; const float* lb = p.in[13]; const float* gws = p.in[14]; const float* gbs = p.in[15];
    const int gw = blockIdx.x * 8 + wave, NGW = gridDim.x * 8;
    if (parts & 1)
    for (int grp = gw; grp < M / 4; grp += NGW) {
        const int m0 = grp * 4, t0 = m0 & (SEQ - 1);
        const int c0 = 8 * lane, c1 = 512 + 8 * lane;
        float a[4][16];
        { const f32x4 b0 = *(const f32x4*)(conv_b + c0), b1 = *(const f32x4*)(conv_b + c0 + 4), b2 = *(const f32x4*)(conv_b + c1), b3 = *(const f32x4*)(conv_b + c1 + 4);
#pragma unroll
          for (int t = 0; t < 4; ++t)
#pragma unroll
            for (int i = 0; i < 4; ++i) { a[t][i] = b0[i]; a[t][4 + i] = b1[i]; a[t][8 + i] = b2[i]; a[t][12 + i] = b3[i]; } }
        float wr[4][16];
#pragma unroll 1
        for (int r4 = 0; r4 < 36; r4 += 4)
#pragma unroll
        for (int ri = 0; ri < 4; ++ri) {
            const int r = r4 + ri;
            if (r >= 34) continue;
            if (r <= 30) {
                const float* cw = conv_w + r * 1024;
                const f32x4 k0 = *(const f32x4*)(cw + c0), k1 = *(const f32x4*)(cw + c0 + 4), k2 = *(const f32x4*)(cw + c1), k3 = *(const f32x4*)(cw + c1 + 4);
#pragma unroll
                for (int i = 0; i < 4; ++i) { wr[ri][i] = k0[i]; wr[ri][4 + i] = k1[i]; wr[ri][8 + i] = k2[i]; wr[ri][12 + i] = k3[i]; }
            }
            if (t0 - 30 + r >= 0) {
                const bf16_t* row = AG + (size_t)(m0 - 30 + r) * 1024;
                const u32x4 x0 = *(const u32x4*)(row + c0), x1 = *(const u32x4*)(row + c1);
                const float x[16] = {bflo(x0.x), bfhi(x0.x), bflo(x0.y), bfhi(x0.y), bflo(x0.z), bfhi(x0.z), bflo(x0.w), bfhi(x0.w),
                                     bflo(x1.x), bfhi(x1.x), bflo(x1.y), bfhi(x1.y), bflo(x1.z), bfhi(x1.z), bflo(x1.w), bfhi(x1.w)};
#pragma unroll
                for (int t = 0; t < 4; ++t) {
                    const int w = r - t;
                    if (w >= 0 && w <= 30) {
#pragma unroll
                        for (int i = 0; i < 16; ++i) a[t][i] += x[i] * wr[(ri - t) & 3][i];
                    }
                }
            }
        }
        const f32x4 g0 = *(const f32x4*)(cg_ + c0), g1 = *(const f32x4*)(cg_ + c0 + 4), g2 = *(const f32x4*)(cg_ + c1), g3 = *(const f32x4*)(cg_ + c1 + 4);
        const f32x4 e0 = *(const f32x4*)(cb_ + c0), e1 = *(const f32x4*)(cb_ + c0 + 4), e2 = *(const f32x4*)(cb_ + c1), e3 = *(const f32x4*)(cb_ + c1 + 4);
#pragma unroll
        for (int t = 0; t < 4; ++t) {
            float sm = 0.f;
#pragma unroll
            for (int i = 0; i < 16; ++i) sm += a[t][i];
            const float mean = wave_sum(sm) * (1.0f / 1024.0f);
            float q = 0.f;
#pragma unroll
            for (int i = 0; i < 16; ++i) { a[t][i] -= mean; q += a[t][i] * a[t][i]; }
            const float rstd = 1.0f / sqrtf(wave_sum(q) * (1.0f / 1024.0f) + EPS);
            float y[16];
#pragma unroll
            for (int i = 0; i < 4; ++i) { y[i] = silu_f(a[t][i] * rstd * g0[i] + e0[i]); y[4 + i] = silu_f(a[t][4 + i] * rstd * g1[i] + e1[i]); y[8 + i] = silu_f(a[t][8 + i] * rstd * g2[i] + e2[i]); y[12 + i] = silu_f(a[t][12 + i] * rstd * g3[i] + e3[i]); }
            u32x4 o0, o1;
            o0.x = cvt_pk_bf16(y[0], y[1]); o0.y = cvt_pk_bf16(y[2], y[3]); o0.z = cvt_pk_bf16(y[4], y[5]); o0.w = cvt_pk_bf16(y[6], y[7]);
            o1.x = cvt_pk_bf16(y[8], y[9]); o1.y = cvt_pk_bf16(y[10], y[11]); o1.z = cvt_pk_bf16(y[12], y[13]); o1.w = cvt_pk_bf16(y[14], y[15]);
            *(u32x4*)(MIX + (size_t)(m0 + t) * 2048 + c0) = o0; *(u32x4*)(MIX + (size_t)(m0 + t) * 2048 + c1) = o1;
        }
    }
    if (parts & 2)
    for (int u = blockIdx.x; u < 512; u += gridDim.x) {
        const int b = u >> 7, chunk = (u >> 3) & 15, g = u & 7;
        const int m0 = b * SEQ + chunk * 128;
        __syncthreads();
        {
            const int s = tid >> 2, q = tid & 3;
            const bf16_t* src = UV + (size_t)(m0 + s) * 2048 + 1024 + g * 128 + 32 * q;
            float x[32];
#pragma unroll
            for (int i = 0; i < 4; ++i) { const u32x4 v = *(const u32x4*)(src + 8 * i);
                x[8 * i + 0] = bflo(v.x); x[8 * i + 1] = bfhi(v.x); x[8 * i + 2] = bflo(v.y); x[8 * i + 3] = bfhi(v.y); x[8 * i + 4] = bflo(v.z); x[8 * i + 5] = bfhi(v.z); x[8 * i + 6] = bflo(v.w); x[8 * i + 7] = bfhi(v.w); }
            float sm = 0.f;
#pragma unroll
            for (int i = 0; i < 32; ++i) sm += x[i];
            sm += __shfl_xor(sm, 1); sm += __shfl_xor(sm, 2);
            const float mean = sm * (1.0f / 128.0f);
            float qq = 0.f;
#pragma unroll
            for (int i = 0; i < 32; ++i) { x[i] -= mean; qq += x[i] * x[i]; }
            qq += __shfl_xor(qq, 1); qq += __shfl_xor(qq, 2);
            const float rstd = 1.0f / sqrtf(qq * (1.0f / 128.0f) + EPS);
            const float* lgp = lg + g * 128 + 32 * q; const float* lbp = lb + g * 128 + 32 * q;
#pragma unroll
            for (int i = 0; i < 32; ++i) {
                const float yv = x[i] * rstd * lgp[i] + lbp[i];
                *(LAS bf16_t*)(lds + (32 * q + i) * 272 + s * 2) = (bf16_t)(cvt_pk_bf16(yv, 0.f) & 0xffffu);
            }
        }
        __syncthreads();
        {
            const int fr = lane & 15, quad = lane >> 4;
            const int trow = 16 * wave + fr;
            f32x4 acc[8];
#pragma unroll
            for (int nd = 0; nd < 8; ++nd) acc[nd] = (f32x4){0.f, 0.f, 0.f, 0.f};
            const int nks = (wave >> 1) + 1;
            bf16x8 Afs[4];
#pragma unroll
            for (int ks = 0; ks < 4; ++ks) {
                u32x4 aw = (u32x4){0u, 0u, 0u, 0u};
                if (ks < nks) {
                    const int s0 = 32 * ks + quad * 8;
                    const float* wp = gws + ((size_t)g * 128 + trow) * 128 + s0;
                    const f32x4 w0 = *(const f32x4*)wp, w1 = *(const f32x4*)(wp + 4);
                    float wv[8] = {w0.x, w0.y, w0.z, w0.w, w1.x, w1.y, w1.z, w1.w};
#pragma unroll
                    for (int j = 0; j < 8; ++j) wv[j] = (s0 + j <= trow) ? wv[j] : 0.f;
                    aw.x = cvt_pk_bf16(wv[0], wv[1]); aw.y = cvt_pk_bf16(wv[2], wv[3]); aw.z = cvt_pk_bf16(wv[4], wv[5]); aw.w = cvt_pk_bf16(wv[6], wv[7]);
                }
                Afs[ks] = __builtin_bit_cast(bf16x8, aw);
            }
#pragma unroll
            for (int ks = 0; ks < 4; ++ks) if (ks < nks) {
                const int s0 = 32 * ks + quad * 8;
#pragma unroll
                for (int nd = 0; nd < 8; ++nd) {
                    const bf16x8 Bf = *(const LAS bf16x8*)(lds + (16 * nd + fr) * 272 + s0 * 2);
                    acc[nd] = __builtin_amdgcn_mfma_f32_16x16x32_bf16(Bf, Afs[ks], acc[nd], 0, 0, 0);
                }
            }
            {
                const int tt = 16 * wave + fr;
                const float bsv = gbs[g * 128 + tt];
                const size_t rowoff = (size_t)(m0 + tt) * 2048;
#pragma unroll
                for (int nd = 0; nd < 8; ++nd) {
                    const int d0 = 16 * nd + 4 * quad;
                    const u32x2 uw = *(const u32x2*)(UV + rowoff + g * 128 + d0);
                    u32x2 ow; ow.x = cvt_pk_bf16(bflo(uw.x) * (acc[nd][0] + bsv), bfhi(uw.x) * (acc[nd][1] + bsv)); ow.y = cvt_pk_bf16(bflo(uw.y) * (acc[nd][2] + bsv), bfhi(uw.y) * (acc[nd][3] + bsv));
                    *(u32x2*)(MIX + rowoff + 1024 + g * 128 + d0) = ow;
                }
            }
        }
    }
}

__device__ __forceinline__ u32x4 scale_chunk(const u32x4 x, float sc) {
    u32x4 w; w.x = cvt_pk_bf16(bflo(x.x) * sc, bfhi(x.x) * sc); w.y = cvt_pk_bf16(bflo(x.y) * sc, bfhi(x.y) * sc); w.z = cvt_pk_bf16(bflo(x.z) * sc, bfhi(x.z) * sc); w.w = cvt_pk_bf16(bflo(x.w) * sc, bfhi(x.w) * sc);
    return w;
}
__device__ __forceinline__ u32x4 rope_chunk(const u32x4 x1, const u32x4 x2, const f32x2* rp, bool first, float sc = 1.0f) {
    float a[8] = {bflo(x1.x), bfhi(x1.x), bflo(x1.y), bfhi(x1.y), bflo(x1.z), bfhi(x1.z), bflo(x1.w), bfhi(x1.w)};
    float b[8] = {bflo(x2.x), bfhi(x2.x), bflo(x2.y), bfhi(x2.y), bflo(x2.z), bfhi(x2.z), bflo(x2.w), bfhi(x2.w)};
    float o[8];
#pragma unroll
    for (int e = 0; e < 8; ++e) { const f32x2 cs = rp[e]; o[e] = (first ? (a[e] * cs.x - b[e] * cs.y) : (b[e] * cs.x + a[e] * cs.y)) * sc; }
    u32x4 w; w.x = cvt_pk_bf16(o[0], o[1]); w.y = cvt_pk_bf16(o[2], o[3]); w.z = cvt_pk_bf16(o[4], o[5]); w.w = cvt_pk_bf16(o[6], o[7]);
    return w;
}
__device__ __forceinline__ void post_phase(const Params& p, LAS unsigned char* lds, int tid) {
    const bf16_t* Z = (const bf16_t*)(p.ws + WS_Z);
    const f32x2* rope = (const f32x2*)(p.ws + WS_ROPE);
    bf16_t* QR = (bf16_t*)(p.ws + WS_QR); bf16_t* KSR = (bf16_t*)(p.ws + WS_KSR); bf16_t* KWR = (bf16_t*)(p.ws + WS_KWR);
    bf16_t* KC = (bf16_t*)(p.ws + WS_KCVC); bf16_t* VC = KC + (size_t)16 * SEQ * 128;
    bf16_t* VST = (bf16_t*)(p.ws + WS_VST); bf16_t* VWT = (bf16_t*)(p.ws + WS_VWT);
    float* GATE = (float*)(p.ws + WS_GATE);
    for (int item = blockIdx.x; item < 256; item += gridDim.x) {
        const int m0 = item * 32, b = m0 >> 11, t0 = m0 & (SEQ - 1);
        for (int idx = tid; idx < 32 * 256; idx += 512) {
            const int row = idx >> 8, ch = idx & 255, hc = ch & 15, m = m0 + row;
            const bf16_t* zr = Z + (size_t)m * ZW;
            u32x4 o;
            if (hc < 4) {
                const int base = (ch & ~15) * 8, i0 = 8 * (hc & 1);
                const u32x4 x1 = *(const u32x4*)(zr + base + i0), x2 = *(const u32x4*)(zr + base + 16 + i0);
                o = rope_chunk(x1, x2, rope + (size_t)m * 16 + i0, hc < 2, SC_LOG2);
            } else o = scale_chunk(*(const u32x4*)(zr + ch * 8), SC_LOG2);
            *(u32x4*)(QR + (size_t)m * 2048 + ch * 8) = o;
        }
        for (int idx = tid; idx < 2 * 32 * 64; idx += 512) {
            const int which = idx >> 11, row = (idx >> 6) & 31, ch = idx & 63, g = ch >> 4, hc = ch & 15, m = m0 + row;
            const int zc = (which == 0) ? 3072 : (which == 1) ? 4096 : (which == 2) ? 2048 : 2560;
            bf16_t* dst = (which == 0) ? KSR : (which == 1) ? KWR : (which == 2) ? KC : VC;
            const bf16_t* zr = Z + (size_t)m * ZW + zc + g * 128;
            u32x4 o;
            if (which < 2 && hc < 4) {
                const int i0 = 8 * (hc & 1);
                const u32x4 x1 = *(const u32x4*)(zr + i0), x2 = *(const u32x4*)(zr + 16 + i0);
                o = rope_chunk(x1, x2, rope + (size_t)m * 16 + i0, hc < 2);
            } else o = *(const u32x4*)(zr + hc * 8);
            *(u32x4*)(dst + ((size_t)(b * 4 + g) * SEQ + t0 + row) * 128 + hc * 8) = o;
        }
        __syncthreads();
        for (int idx = tid; idx < 2 * 32 * 64; idx += 512) { const int which = idx >> 11, row = (idx >> 6) & 31, ch = idx & 63;
            *(LAS u32x4*)(lds + which * 33280 + row * 1040 + ch * 16) = *(const u32x4*)(Z + (size_t)(m0 + row) * ZW + (which ? 4608 : 3584) + ch * 8); }
        __syncthreads();
#pragma unroll
        for (int which = 0; which < 2; ++which) {
            bf16_t* dst = which ? VWT : VST;
            const int g = tid >> 7, d = tid & 127;
            unsigned w[16];
#pragma unroll
            for (int i = 0; i < 16; ++i) { const unsigned lo = *(const LAS bf16_t*)(lds + which * 33280 + (2 * i) * 1040 + tid * 2), hi = *(const LAS bf16_t*)(lds + which * 33280 + (2 * i + 1) * 1040 + tid * 2); w[i] = lo | (hi << 16); }
            u32x4* o = (u32x4*)(dst + ((size_t)(b * 4 + g) * 128 + d) * SEQ + t0);
            o[0] = (u32x4){w[0], w[1], w[2], w[3]}; o[1] = (u32x4){w[4], w[5], w[6], w[7]}; o[2] = (u32x4){w[8], w[9], w[10], w[11]}; o[3] = (u32x4){w[12], w[13], w[14], w[15]};
        }
        for (int idx = tid; idx < 32 * 48; idx += 512) { const int row = idx / 48, c = idx - row * 48, m = m0 + row;
            GATE[(size_t)m * 48 + c] = sigmoid_f(bf1(Z[(size_t)m * ZW + 5120 + c])); }
    }
    if (blockIdx.x == 0) {
        const float* PB = (const float*)(p.ws + WS_PB); float* CB = (float*)(p.ws + WS_CBIAS);
        const int kv = tid >> 8, c = tid & 255; float s = 0.f;
        for (int kc = 0; kc < 64; ++kc) s += PB[(kv * 64 + kc) * 256 + c];
        CB[tid] = s;
    }
}

__device__ __forceinline__ void cmp2_phase(const Params& p, LAS unsigned char* lds, int tid) {
    const float* P = (const float*)(p.ws + WS_H1P); const float* CB = (const float*)(p.ws + WS_CBIAS);
    bf16_t* KCMP = (bf16_t*)(p.ws + WS_KCMP); bf16_t* VCMPT = (bf16_t*)(p.ws + WS_VCMPT);
    LAS float* H = (LAS float*)lds;
    for (int rb = blockIdx.x; rb < 256; rb += gridDim.x) {
        const int r0 = rb * 16;
        __syncthreads();
        {
            const int row = tid >> 5, c8 = (tid & 31) * 8, r = r0 + row;
            f32x4 s0 = *(const f32x4*)(CB + (r >> 11) * 256 + c8), s1 = *(const f32x4*)(CB + (r >> 11) * 256 + c8 + 4);
#pragma unroll
            for (int k = 0; k < 8; ++k) { const float* pp = P + ((size_t)k * 4096 + r) * 256 + c8; s0 = s0 + *(const f32x4*)pp; s1 = s1 + *(const f32x4*)(pp + 4); }
            LAS float* hp = H + row * 256 + c8;
            *(LAS f32x4*)hp = (f32x4){gelu_f(s0[0]), gelu_f(s0[1]), gelu_f(s0[2]), gelu_f(s0[3])};
            *(LAS f32x4*)(hp + 4) = (f32x4){gelu_f(s1[0]), gelu_f(s1[1]), gelu_f(s1[2]), gelu_f(s1[3])};
        }
        __syncthreads();
        {
            const int d = tid & 127, rq = tid >> 7;
            const float* w2 = p.in[(r0 < 2048) ? 29 : 32];
            const LAS float* hp = H + (rq * 4) * 256;
            float a0 = 0.f, a1 = 0.f, a2 = 0.f, a3 = 0.f;
#pragma unroll 8
            for (int c = 0; c < 256; ++c) { const float w = w2[c * 128 + d]; a0 += hp[c] * w; a1 += hp[256 + c] * w; a2 += hp[512 + c] * w; a3 += hp[768 + c] * w; }
            const float av[4] = {a0, a1, a2, a3};
#pragma unroll
            for (int i = 0; i < 4; ++i) {
                const int r = r0 + rq * 4 + i; const bf16_t o = (bf16_t)(cvt_pk_bf16(av[i], 0.f) & 0xffffu);
                if (r < 2048) KCMP[(size_t)r * 128 + d] = o;
                else { const int rr = r - 2048, bg = rr >> 7, n = rr & 127; VCMPT[((size_t)bg * 128 + d) * 128 + n] = o; }
            }
        }
    }
}

constexpr int A_KS = 0, A_VS = 34816, A_IMP = 69632, A_FIMP = 102400, A_MASK = 110592;

struct KVPre { u32x4 k0, k1, v0, v1; };
__device__ __forceinline__ void kv_issue(KVPre& r, const bf16_t* Kg, const bf16_t* VTg, int tid) {
    const int row = tid >> 4, ch = tid & 15, vrow = tid >> 3, vch = tid & 7;
    r.k0 = *(const u32x4*)(Kg + (size_t)row * 128 + ch * 8); r.k1 = *(const u32x4*)(Kg + (size_t)(row + 32) * 128 + ch * 8);
    r.v0 = *(const u32x4*)(VTg + (size_t)vrow * SEQ + vch * 8); r.v1 = *(const u32x4*)(VTg + (size_t)(vrow + 64) * SEQ + vch * 8);
}
template <int MODE>
__device__ __forceinline__ void attn_block(LAS unsigned char* lds, KVPre& pre, const bf16_t* nK, const bf16_t* nVT, int j, const bool full,
                                           const bf16x8 (&Qf)[2][4], f32x4 (&O)[2][8], float (&mrun)[2], float (&lrun)[2],
                                           const int (&tq)[2], const unsigned (&selw)[2], int tid, int fr, int quad) {
    __syncthreads();
    {
        const int row = tid >> 4, ch = tid & 15, vrow = tid >> 3, vch = tid & 7;
        LAS unsigned char* kd = lds + A_KS + row * 272 + ch * 16; LAS unsigned char* vd = lds + A_VS + vrow * 144 + vch * 16;
        *(LAS u32x4*)kd = pre.k0; *(LAS u32x4*)(kd + 32 * 272) = pre.k1; *(LAS u32x4*)vd = pre.v0; *(LAS u32x4*)(vd + 64 * 144) = pre.v1;
    }
    __syncthreads();
    if (nK) kv_issue(pre, nK, nVT, tid);
    const LAS unsigned char* kbase = lds + A_KS + fr * 272 + quad * 16;
    const LAS unsigned char* vbase = lds + A_VS + fr * 144 + quad * 8;
    f32x4 S[2][4];
#pragma unroll
    for (int qt = 0; qt < 2; ++qt)
#pragma unroll
        for (int kt = 0; kt < 4; ++kt) S[qt][kt] = (f32x4){0.f, 0.f, 0.f, 0.f};
#pragma unroll
    for (int kt = 0; kt < 4; ++kt)
#pragma unroll
        for (int kk = 0; kk < 4; ++kk) {
            const bf16x8 Kf = *(const LAS bf16x8*)(kbase + kt * 4352 + kk * 64);
#pragma unroll
            for (int qt = 0; qt < 2; ++qt) S[qt][kt] = __builtin_amdgcn_mfma_f32_16x16x32_bf16(Kf, Qf[qt][kk], S[qt][kt], 0, 0, 0);
        }
    bf16x8 Pf[2][2];
#pragma unroll
    for (int qt = 0; qt < 2; ++qt) {
        const int d0 = tq[qt] - 64 * j - 4 * quad;
        const float selpen = (MODE == 0) ? ((((selw[qt] >> j) & 1u) != 0u) ? 0.f : -1e30f) : 0.f;
        float mx = -3e38f;
        if (full) {
#pragma unroll
            for (int kt = 0; kt < 4; ++kt)
#pragma unroll
                for (int r = 0; r < 4; ++r) { const float s = S[qt][kt][r] + selpen; S[qt][kt][r] = s; mx = fmaxf(mx, s); }
        } else {
#pragma unroll
            for (int kt = 0; kt < 4; ++kt)
#pragma unroll
                for (int r = 0; r < 4; ++r) {
                    const int dv = d0 - (16 * kt + r);
                    int dm = dv < 0 ? dv : 0;
                    if (MODE == 1) { const int d2 = 511 - dv; dm = d2 < dm ? d2 : dm; }
                    const float s = S[qt][kt][r] + ((float)dm * 1e30f + selpen);
                    S[qt][kt][r] = s; mx = fmaxf(mx, s);
                }
        }
        mx = fmaxf(mx, __shfl_xor(mx, 16)); mx = fmaxf(mx, __shfl_xor(mx, 32));
        if (__any(mx > mrun[qt] + 8.0f)) {
            const float mnew = fmaxf(mrun[qt], mx);
            const float alpha = __builtin_amdgcn_exp2f(mrun[qt] - mnew);
            lrun[qt] *= alpha; mrun[qt] = mnew;
#pragma unroll
            for (int dd = 0; dd < 8; ++dd) O[qt][dd] = O[qt][dd] * alpha;
        }
        const float msub = (mrun[qt] > -1e29f) ? mrun[qt] : 1e30f;
        float rs = 0.f;
#pragma unroll
        for (int kt = 0; kt < 4; ++kt)
#pragma unroll
            for (int r = 0; r < 4; ++r) { const float pv = __builtin_amdgcn_exp2f(S[qt][kt][r] - msub); S[qt][kt][r] = pv; rs += pv; }
        lrun[qt] += rs;
#pragma unroll
        for (int ks = 0; ks < 2; ++ks) {
            u32x4 pp; pp.x = cvt_pk_bf16(S[qt][2 * ks][0], S[qt][2 * ks][1]); pp.y = cvt_pk_bf16(S[qt][2 * ks][2], S[qt][2 * ks][3]);
            pp.z = cvt_pk_bf16(S[qt][2 * ks + 1][0], S[qt][2 * ks + 1][1]); pp.w = cvt_pk_bf16(S[qt][2 * ks + 1][2], S[qt][2 * ks + 1][3]);
            Pf[qt][ks] = __builtin_bit_cast(bf16x8, pp);
        }
    }
#pragma unroll
    for (int ks = 0; ks < 2; ++ks)
#pragma unroll
        for (int dd = 0; dd < 8; ++dd) {
            const LAS unsigned char* vp = vbase + dd * 2304 + ks * 64;
            const u32x2 va = *(const LAS u32x2*)vp, vb = *(const LAS u32x2*)(vp + 32);
            const bf16x8 Vf = __builtin_bit_cast(bf16x8, ((u32x4){va.x, va.y, vb.x, vb.y}));
#pragma unroll
            for (int qt = 0; qt < 2; ++qt) O[qt][dd] = __builtin_amdgcn_mfma_f32_16x16x32_bf16(Vf, Pf[qt][ks], O[qt][dd], 0, 0, 0);
        }
}

__device__ __forceinline__ void attn_tile(const Params& p, LAS unsigned char* lds, int bg, int c, int tid_in) {
    int tid = tid_in; asm volatile("" : "+v"(tid));
    const int lane = tid & 63, wave = __builtin_amdgcn_readfirstlane(tid >> 6);
    const bf16_t* Z = (const bf16_t*)(p.ws + WS_Z); const bf16_t* QR = (const bf16_t*)(p.ws + WS_QR);
    const bf16_t* KSR = (const bf16_t*)(p.ws + WS_KSR); const bf16_t* KWR = (const bf16_t*)(p.ws + WS_KWR);
    const bf16_t* VST = (const bf16_t*)(p.ws + WS_VST); const bf16_t* VWT = (const bf16_t*)(p.ws + WS_VWT);
    const bf16_t* KCMP = (const bf16_t*)(p.ws + WS_KCMP); const bf16_t* VCMPT = (const bf16_t*)(p.ws + WS_VCMPT);
    const float* GATE = (const float*)(p.ws + WS_GATE);
    float* OACC = (float*)(p.ws + WS_OACC); bf16_t* OB = (bf16_t*)(p.ws + WS_OB);
    const int b = bg >> 2, g = bg & 3, t0 = c * 64, m0 = b * SEQ + t0;
    const int h = wave & 3, th = wave >> 2, fr = lane & 15, quad = lane >> 4, head = g * 4 + h;
    int tq[2], mrow[2], tl[2];
#pragma unroll
    for (int qt = 0; qt < 2; ++qt) { tl[qt] = 32 * th + 16 * qt + fr; tq[qt] = t0 + tl[qt]; mrow[qt] = m0 + tl[qt]; }
    LAS float* IMP = (LAS float*)(lds + A_IMP); LAS float* FIMP = (LAS float*)(lds + A_FIMP); LAS unsigned* MASK = (LAS unsigned*)(lds + A_MASK);
    bf16x8 Qf[2][4];
    f32x4 O[2][8];

    __syncthreads();
    {
        const bf16_t* kc = KCMP + (size_t)bg * 128 * 128; const bf16_t* vc = VCMPT + (size_t)bg * 128 * 128;
        const int row = tid >> 4, ch = tid & 15;
        LAS unsigned char* kd = lds + A_KS + row * 272 + ch * 16; LAS unsigned char* vd = lds + A_VS + row * 272 + ch * 16;
#pragma unroll
        for (int i = 0; i < 4; ++i) {
            *(LAS u32x4*)(kd + i * 32 * 272) = *(const u32x4*)(kc + (size_t)(row + 32 * i) * 128 + ch * 8);
            *(LAS u32x4*)(vd + i * 32 * 272) = *(const u32x4*)(vc + (size_t)(row + 32 * i) * 128 + ch * 8); }
        if (tid < 64) MASK[tid] = 0u;
    }
#pragma unroll
    for (int qt = 0; qt < 2; ++qt)
#pragma unroll
        for (int kk = 0; kk < 4; ++kk) Qf[qt][kk] = *(const bf16x8*)(Z + (size_t)mrow[qt] * ZW + head * 128 + kk * 32 + quad * 8);
    __syncthreads();
    {
        const int nkt = (c >> 2) + 1;
        const LAS unsigned char* kbase = lds + A_KS + fr * 272 + quad * 16;
        const LAS unsigned char* vbase = lds + A_VS + fr * 272 + quad * 8;
        f32x4 S[2][8];
#pragma unroll
        for (int qt = 0; qt < 2; ++qt)
#pragma unroll
            for (int kt = 0; kt < 8; ++kt) S[qt][kt] = (f32x4){0.f, 0.f, 0.f, 0.f};
#pragma unroll
        for (int kt = 0; kt < 8; ++kt) if (kt < nkt) {
#pragma unroll
            for (int kk = 0; kk < 4; ++kk) {
                const bf16x8 Kf = *(const LAS bf16x8*)(kbase + kt * 4352 + kk * 64);
#pragma unroll
                for (int qt = 0; qt < 2; ++qt) S[qt][kt] = __builtin_amdgcn_mfma_f32_16x16x32_bf16(Kf, Qf[qt][kk], S[qt][kt], 0, 0, 0);
            }
        }
#pragma unroll
        for (int qt = 0; qt < 2; ++qt) {
            const int d0 = tq[qt] - 31 - 64 * quad;
            float mx = -3e38f;
#pragma unroll
            for (int kt = 0; kt < 8; ++kt) if (kt < nkt)
#pragma unroll
                for (int r = 0; r < 4; ++r) { const int dv = d0 - (256 * kt + 16 * r); const int dm = dv < 0 ? dv : 0;
                    const float s = S[qt][kt][r] * SC_LOG2 + (float)dm * 1e30f; S[qt][kt][r] = s; mx = fmaxf(mx, s); }
            mx = fmaxf(mx, __shfl_xor(mx, 16)); mx = fmaxf(mx, __shfl_xor(mx, 32));
            const float msub = (mx > -1e29f) ? mx : 1e30f;
            float rs = 0.f;
#pragma unroll
            for (int kt = 0; kt < 8; ++kt) if (kt < nkt)
#pragma unroll
                for (int r = 0; r < 4; ++r) { const float pv = __builtin_amdgcn_exp2f(S[qt][kt][r] - msub); S[qt][kt][r] = pv; rs += pv; }
            rs += __shfl_xor(rs, 16); rs += __shfl_xor(rs, 32);
            const float inv = rs > 0.f ? 1.0f / rs : 0.f;
#pragma unroll
            for (int kt = 0; kt < 8; ++kt) if (kt < nkt) S[qt][kt] = S[qt][kt] * inv;
            const int src = (lane + 48) & 63;
            float prev3 = 0.f;
            LAS float* ip = IMP + (h * 64 + tl[qt]) * 32 + quad;
#pragma unroll
            for (int kt = 0; kt < 8; ++kt) {
                const float gsum = (S[qt][kt][0] + S[qt][kt][1]) + (S[qt][kt][2] + S[qt][kt][3]);
                const float a = __shfl(S[qt][kt][3], src);
                const float e = (quad > 0) ? a : prev3;
                prev3 = a;
                ip[4 * kt] = gsum + e;
            }
        }
#pragma unroll
        for (int qt = 0; qt < 2; ++qt)
#pragma unroll
            for (int dd = 0; dd < 8; ++dd) O[qt][dd] = (f32x4){0.f, 0.f, 0.f, 0.f};
#pragma unroll
        for (int ks = 0; ks < 4; ++ks) if (2 * ks < nkt) {
            bf16x8 Pf[2];
#pragma unroll
            for (int qt = 0; qt < 2; ++qt) {
                u32x4 pp; pp.x = cvt_pk_bf16(S[qt][2 * ks][0], S[qt][2 * ks][1]); pp.y = cvt_pk_bf16(S[qt][2 * ks][2], S[qt][2 * ks][3]);
                pp.z = cvt_pk_bf16(S[qt][2 * ks + 1][0], S[qt][2 * ks + 1][1]); pp.w = cvt_pk_bf16(S[qt][2 * ks + 1][2], S[qt][2 * ks + 1][3]);
                Pf[qt] = __builtin_bit_cast(bf16x8, pp);
            }
#pragma unroll
            for (int dd = 0; dd < 8; ++dd) {
                const LAS unsigned char* vp = vbase + dd * 4352 + ks * 64;
                const u32x2 va = *(const LAS u32x2*)vp, vb = *(const LAS u32x2*)(vp + 32);
                const bf16x8 Vf = __builtin_bit_cast(bf16x8, ((u32x4){va.x, va.y, vb.x, vb.y}));
#pragma unroll
                for (int qt = 0; qt < 2; ++qt) O[qt][dd] = __builtin_amdgcn_mfma_f32_16x16x32_bf16(Vf, Pf[qt], O[qt][dd], 0, 0, 0);
            }
        }
#pragma unroll
        for (int qt = 0; qt < 2; ++qt) {
            const float gc = GATE[(size_t)mrow[qt] * 48 + head * 3 + 0];
            float* op = OACC + (size_t)mrow[qt] * 2048 + head * 128 + 4 * quad;
#pragma unroll
            for (int dd = 0; dd < 8; ++dd) *(f32x4*)(op + 16 * dd) = O[qt][dd] * gc;
#if DBG_DUMP
            { bf16_t* dp = (bf16_t*)(p.ws + (WS_W + 132 * MiB)) + (size_t)mrow[qt] * 2048 + head * 128 + 4 * quad;
#pragma unroll
              for (int dd = 0; dd < 8; ++dd) { u32x2 w; w.x = cvt_pk_bf16(O[qt][dd][0], O[qt][dd][1]); w.y = cvt_pk_bf16(O[qt][dd][2], O[qt][dd][3]); *(u32x2*)(dp + 16 * dd) = w; } }
#endif
        }
    }
    __syncthreads();
    {
        const int tok = tid >> 3, jg = tid & 7;
#pragma unroll
        for (int e = 0; e < 4; ++e) {
            const int j = 4 * jg + e;
            float v = (IMP[(0 * 64 + tok) * 32 + j] + IMP[(1 * 64 + tok) * 32 + j]) + (IMP[(2 * 64 + tok) * 32 + j] + IMP[(3 * 64 + tok) * 32 + j]);
            if (j == 0 || j == c || j == c - 1) v += 1000.0f;
            FIMP[tok * 32 + j] = (j <= c) ? v : -1e30f;
        }
    }
    __syncthreads();
    {
        const int tok = tid >> 3, jg = tid & 7;
        unsigned bits = 0u;
#pragma unroll 1
        for (int e = 0; e < 4; ++e) {
            const int j = 4 * jg + e; const float vj = FIMP[tok * 32 + j]; int rank = 0;
#pragma unroll 4
            for (int j2 = 0; j2 < 32; ++j2) { const float v2 = FIMP[tok * 32 + j2]; rank += (v2 > vj || (v2 == vj && j2 < j)) ? 1 : 0; }
            if (j <= c && rank < 16) bits |= (1u << j);
        }
        if (bits) __hip_atomic_fetch_or(MASK + tok, bits, __ATOMIC_RELAXED, __HIP_MEMORY_SCOPE_WORKGROUP);
    }
    __syncthreads();
    unsigned selw[2]; unsigned U;
    {
        selw[0] = MASK[tl[0]]; selw[1] = MASK[tl[1]];
        unsigned mw = MASK[lane];
#pragma unroll
        for (int o = 1; o < 64; o <<= 1) mw |= (unsigned)__shfl_xor((int)mw, o);
        U = (unsigned)__builtin_amdgcn_readfirstlane((int)mw);
    }
#pragma unroll
    for (int qt = 0; qt < 2; ++qt)
#pragma unroll
        for (int kk = 0; kk < 4; ++kk) Qf[qt][kk] = *(const bf16x8*)(QR + (size_t)mrow[qt] * 2048 + head * 128 + kk * 32 + quad * 8);
    float mrun[2], lrun[2];
#pragma unroll
    for (int qt = 0; qt < 2; ++qt) { mrun[qt] = -1e30f; lrun[qt] = 0.f;
#pragma unroll
        for (int dd = 0; dd < 8; ++dd) O[qt][dd] = (f32x4){0.f, 0.f, 0.f, 0.f}; }
    KVPre pre;
    const int jw0 = (c >= 8) ? c - 8 : 0;
    kv_issue(pre, KSR + (size_t)bg * SEQ * 128, VST + (size_t)bg * 128 * SEQ, tid);
    {
        int j = 0;
#pragma unroll 1
        for (;;) {
            const unsigned rest = (j < 31) ? (U >> (j + 1)) : 0u;
            const int nj = rest ? (j + 1 + __builtin_ctz(rest)) : -1;
            const bf16_t* nK = (nj >= 0) ? KSR + ((size_t)bg * SEQ + 64 * nj) * 128 : KWR + ((size_t)bg * SEQ + 64 * jw0) * 128;
            const bf16_t* nV = (nj >= 0) ? VST + (size_t)bg * 128 * SEQ + 64 * nj : VWT + (size_t)bg * 128 * SEQ + 64 * jw0;
            attn_block<0>(lds, pre, nK, nV, j, j < c, Qf, O, mrun, lrun, tq, selw, tid, fr, quad);
            if (nj < 0) break;
            j = nj;
        }
    }
#pragma unroll
    for (int qt = 0; qt < 2; ++qt) {
        float lt = lrun[qt]; lt += __shfl_xor(lt, 16); lt += __shfl_xor(lt, 32);
        const float gs = GATE[(size_t)mrow[qt] * 48 + head * 3 + 1] * (lt > 0.f ? 1.0f / lt : 0.f);
        float* op = OACC + (size_t)mrow[qt] * 2048 + head * 128 + 4 * quad;
#pragma unroll
        for (int dd = 0; dd < 8; ++dd) { const f32x4 prev = *(const f32x4*)(op + 16 * dd); *(f32x4*)(op + 16 * dd) = prev + O[qt][dd] * gs; }
#if DBG_DUMP
        { const float il = (lrun[qt] > 0.f ? 1.0f / lrun[qt] : 0.f); bf16_t* dp = (bf16_t*)(p.ws + (WS_W + 164 * MiB)) + (size_t)mrow[qt] * 2048 + head * 128 + 4 * quad;
#pragma unroll
          for (int dd = 0; dd < 8; ++dd) { u32x2 w; w.x = cvt_pk_bf16(O[qt][dd][0] * il, O[qt][dd][1] * il); w.y = cvt_pk_bf16(O[qt][dd][2] * il, O[qt][dd][3] * il); *(u32x2*)(dp + 16 * dd) = w; }
          if (h == 0) ((unsigned*)(p.ws + (WS_W + 130 * MiB)))[(size_t)mrow[qt] * 4 + g] = selw[qt]; }
#endif
    }
#pragma unroll
    for (int qt = 0; qt < 2; ++qt) { mrun[qt] = -1e30f; lrun[qt] = 0.f;
#pragma unroll
        for (int dd = 0; dd < 8; ++dd) O[qt][dd] = (f32x4){0.f, 0.f, 0.f, 0.f}; }
#pragma unroll 1
    for (int j = jw0; j <= c; ++j) {
        const bf16_t* nK = (j < c) ? KWR + ((size_t)bg * SEQ + 64 * (j + 1)) * 128 : nullptr;
        const bf16_t* nV = (j < c) ? VWT + (size_t)bg * 128 * SEQ + 64 * (j + 1) : nullptr;
        attn_block<1>(lds, pre, nK, nV, j, (j < c) && (j + 7 >= c), Qf, O, mrun, lrun, tq, selw, tid, fr, quad);
    }
#pragma unroll
    for (int qt = 0; qt < 2; ++qt) {
        float lt = lrun[qt]; lt += __shfl_xor(lt, 16); lt += __shfl_xor(lt, 32);
        const float gwv = GATE[(size_t)mrow[qt] * 48 + head * 3 + 2] * (lt > 0.f ? 1.0f / lt : 0.f);
        const float* op = OACC + (size_t)mrow[qt] * 2048 + head * 128 + 4 * quad;
        bf16_t* ob = OB + (size_t)mrow[qt] * 2048 + head * 128 + 4 * quad;
#pragma unroll
        for (int dd = 0; dd < 8; ++dd) { const f32x4 v = *(const f32x4*)(op + 16 * dd) + O[qt][dd] * gwv;
            u32x2 w; w.x = cvt_pk_bf16(v[0], v[1]); w.y = cvt_pk_bf16(v[2], v[3]); *(u32x2*)(ob + 16 * dd) = w; }
#if DBG_DUMP
        { const float il = (lrun[qt] > 0.f ? 1.0f / lrun[qt] : 0.f); bf16_t* dp = (bf16_t*)(p.ws + (WS_W + 98 * MiB)) + (size_t)mrow[qt] * 2048 + head * 128 + 4 * quad;
#pragma unroll
          for (int dd = 0; dd < 8; ++dd) { u32x2 w; w.x = cvt_pk_bf16(O[qt][dd][0] * il, O[qt][dd][1] * il); w.y = cvt_pk_bf16(O[qt][dd][2] * il, O[qt][dd][3] * il); *(u32x2*)(dp + 16 * dd) = w; } }
#endif
    }
}
__device__ __forceinline__ void attn_phase(const Params& p, LAS unsigned char* lds, int tid, int lane, int wave) {
#pragma unroll 1
    for (int it = blockIdx.x; it < 256; it += gridDim.x) {
        const int bg = it >> 4, cc = it & 15;
#pragma unroll 1
        for (int half = 0; half < 2; ++half) attn_tile(p, lds, bg, half ? cc : 31 - cc, tid);
    }
}


#define XB_TMO      128
#define XB_XCNT(j)  (256  + 64 * (j))
#define XB_XSUB(j)  (1280 + 64 * (j))
#define XB_XGEN(j)  (2304 + 64 * (j))
#define XB_TOP      3328
#define XB_TOPGEN   3392
#define XCD_BAR_WORDS 3456
#define XB_SPIN_CAP (1u << 18)
__device__ __forceinline__ unsigned xb_ld(unsigned* p)              { return __hip_atomic_load(p, __ATOMIC_RELAXED, __HIP_MEMORY_SCOPE_AGENT); }
__device__ __forceinline__ unsigned xb_add(unsigned* p, unsigned v) { return __hip_atomic_fetch_add(p, v, __ATOMIC_RELAXED, __HIP_MEMORY_SCOPE_AGENT); }
__device__ __forceinline__ unsigned xb_xcc_id() { return (unsigned)__builtin_amdgcn_s_getreg((3 << 11) | 20) & 0xFu; }
#define XB_SPIN(cond, bar) do { unsigned _sp = 0; while (cond) { __builtin_amdgcn_s_sleep(1); \
    if ((++_sp & 255u) == 0u) { if (xb_ld(&(bar)[XB_TMO])) break; if (_sp > XB_SPIN_CAP) { atomicAdd(&(bar)[XB_TMO], 1u); break; } } } } while (0)
struct XcdBarrier { unsigned* bar; unsigned x; volatile LAS unsigned* st; };
__device__ __forceinline__ XcdBarrier xcd_barrier_post(unsigned* bar, volatile LAS unsigned* st) {
    XcdBarrier b; b.bar = bar; b.x = xb_xcc_id(); b.st = st;
    if (threadIdx.x == 0) (void)xb_add(&bar[XB_XCNT(b.x)], 1u);
    return b;
}
__device__ __forceinline__ void xcd_barrier_complete(unsigned* bar, unsigned x, unsigned& nloc, unsigned& nx) {
    const unsigned G = gridDim.x * gridDim.y * gridDim.z;
    unsigned sum, cnt, mine, sp = 0u;
    for (;;) {
        sum = 0u; cnt = 0u; mine = 0u;
#pragma unroll
        for (unsigned j = 0; j < 16; ++j) { const unsigned c = xb_ld(&bar[XB_XCNT(j)]); sum += c; cnt += (c > 0u) ? 1u : 0u; mine = (j == x) ? c : mine; }
        if (sum == G) break;
        __builtin_amdgcn_s_sleep(1);
        if ((++sp & 255u) == 0u) { if (xb_ld(&bar[XB_TMO])) break; if (sp > XB_SPIN_CAP) { atomicAdd(&bar[XB_TMO], 1u); break; } }
    }
    nloc = mine > 0u ? mine : 1u; nx = cnt > 0u ? cnt : 1u;
}
__device__ __forceinline__ void xcd_barrier(const XcdBarrier& b) {
    asm volatile("s_waitcnt vmcnt(0)" ::: "memory");
    __syncthreads();
    if (threadIdx.x == 0) {
        unsigned* bar = b.bar;
        __builtin_amdgcn_s_waitcnt(0);
        unsigned nloc = b.st[0], nx = b.st[1];
        if (nloc == 0u) { xcd_barrier_complete(bar, b.x, nloc, nx); b.st[0] = nloc; b.st[1] = nx; }
        const unsigned old = xb_add(&bar[XB_XSUB(b.x)], 1u);
        const unsigned gen = old / nloc;
        if (old + 1u == (gen + 1u) * nloc) {
            __builtin_amdgcn_fence(__ATOMIC_RELEASE, "agent");
            asm volatile("s_waitcnt vmcnt(0)" ::: "memory");
            const unsigned og = xb_add(&bar[XB_TOP], 1u);
            const unsigned tg = og / nx;
            if (og + 1u == (tg + 1u) * nx) xb_add(&bar[XB_TOPGEN], 1u);
            else XB_SPIN(xb_ld(&bar[XB_TOPGEN]) == tg, bar);
            __builtin_amdgcn_fence(__ATOMIC_ACQUIRE, "agent");
            xb_add(&bar[XB_XGEN(b.x)], 1u);
            asm volatile("s_waitcnt vmcnt(0)" ::: "memory");
        } else {
            XB_SPIN(xb_ld(&bar[XB_XGEN(b.x)]) == gen, bar);
            __builtin_amdgcn_fence(__ATOMIC_ACQUIRE, "agent");
            asm volatile("s_waitcnt vmcnt(0)" ::: "memory");
        }
    }
    __syncthreads();
}
constexpr size_t WS_BAR = 3 * MiB + 768 * 1024;
constexpr int MISC_OFF = 131072 + 320;

#define RUN(k) (p.ph_lo <= (k) && (k) < p.ph_hi)
#define SEAM(k) do { if (p.ph_lo <= (k) && (k) + 1 < p.ph_hi) { if (p.ph_lo < -5) grid.sync(); else xcd_barrier(xbar); } } while (0)
#define TIDS int tid = threadIdx.x; asm volatile("" : "+v"(tid)); const int lane = tid & 63, wave = __builtin_amdgcn_readfirstlane(tid >> 6); (void)lane; (void)wave

template <int F, int K0, int SSI>
__device__ __forceinline__ void ffn_block(const Params& p, LAS unsigned char* lds, cg::grid_group& grid, const XcdBarrier& xbar, const float* xin, const float* normw) {
    unsigned char* ws = p.ws;
    float* X = (float*)(ws + WS_X); bf16_t* HN = (bf16_t*)(ws + WS_HN); bf16_t* ACT = (bf16_t*)(ws + WS_ACT);
    ss_t* SS = (ss_t*)(ws + WS_SS);
    if (RUN(K0 + 1)) { TIDS;
        pg8::Gemm g{HN, (const bf16_t*)(ws + WS_WGU(F)), M, 2 * FF, D, D, D};
        pg8::StaticOrder S; S.init(M, 2 * FF, gridDim.x, blockIdx.x);
        pg8::EpiSwiGLU E{ACT, SS + (size_t)SSI * M};
        pg8::gemm_phase(lds, g, S, E, tid);
        {
            const int half = (int)gridDim.x / 2, CAP = 4608;
            const int gwv = (int)blockIdx.x * 8 + wave, ngw = (int)gridDim.x * 8;
            const int widx = ((int)blockIdx.x - half) * 8 + wave, nw = ((int)gridDim.x - half) * 8;
            const bool upper = (int)blockIdx.x >= half;
            if (F < 2) {
                const int lo = p.tstart[3 * F + 2], hi = p.tstart[3 * F + 5], mid = (lo + CAP < hi) ? lo + CAP : hi;
                if (upper) convert_range(p, lo, mid, widx, nw, lane);
                convert_range(p, mid, hi, gwv, ngw, lane);
            }
            if (F == 2) {
                const int lo2 = p.tstart[16], hi2 = p.tstart[20], mid2 = (lo2 + (CAP - 2816) < hi2) ? lo2 + (CAP - 2816) : hi2;
                if (upper) { convert_range(p, p.tstart[8], p.tstart[9], widx, nw, lane); convert_range(p, lo2, mid2, widx, nw, lane); }
                convert_range(p, mid2, hi2, gwv, ngw, lane);
            }
            if (F == 3) { if (upper) convert_range(p, p.tstart[11], p.tstart[12], widx, nw, lane); }
        }
#if PROBE_UP
        pg8::gemm_phase(lds, g, S, E, tid);
#endif
        }
    SEAM(K0 + 1);
    if (RUN(K0 + 2)) { TIDS;
        pg8::Gemm g{ACT, (const bf16_t*)(ws + WS_WD(F)), M, D, FF, FF, FF};
        pg8::StaticOrder S; S.init(M, D, gridDim.x, blockIdx.x);
        if (F == 3 && gridDim.x == 256) {
            pg8::EpiResidFinal E{HN, SS + (size_t)(SSI + 1) * M, (unsigned*)(ws + WS_CNT), p.in[38], p.out};
            pg8::gemm_phase(lds, g, S, E, tid);
        } else {
            pg8::EpiResid<true, F == 0> E{xin, HN, SS + (size_t)(SSI + 1) * M};
            pg8::gemm_phase(lds, g, S, E, tid);
        } }
    if (F < 3 || gridDim.x != 256) SEAM(K0 + 2);
}

__global__ void __launch_bounds__(512, 2) fwd_kernel(Params p) {
    extern __shared__ __attribute__((aligned(16))) unsigned char lds_raw[];
    LAS unsigned char* lds = (LAS unsigned char*)lds_raw;
    cg::grid_group grid = cg::this_grid();
    unsigned char* ws = p.ws;
    float* X = (float*)(ws + WS_X); bf16_t* HN = (bf16_t*)(ws + WS_HN);
    XcdBarrier xbar; xbar.bar = (unsigned*)(ws + WS_BAR); xbar.x = 0; xbar.st = nullptr;
    if (p.ph_hi - p.ph_lo > 1) {
        volatile LAS unsigned* misc = (volatile LAS unsigned*)(lds + MISC_OFF);
        if (threadIdx.x < 32) misc[threadIdx.x] = 0u;
        __syncthreads();
        xbar = xcd_barrier_post((unsigned*)(ws + WS_BAR), misc + 8);
    }

    if (RUN(0)) { TIDS; prologue_phase(p, lds, tid, wave, lane); }
#if PROBE_PRO
    if (RUN(0)) { TIDS; prologue_phase(p, lds, tid, wave, lane); }
#endif
    SEAM(0);
    ffn_block<0, 1, 0>(p, lds, grid, xbar, p.in[0], p.in[2]);
    ss_t* SS = (ss_t*)(ws + WS_SS);
    if (RUN(5)) { TIDS;
        pg8::Gemm g{HN, (const bf16_t*)(ws + WS_WIN0), M, 4096, D, D, D};
        pg8::StaticOrder S; S.init(M, 4096, gridDim.x, blockIdx.x);
        pg8::EpiL0In E{(bf16_t*)(ws + WS_AG), (bf16_t*)(ws + WS_UV), SS + (size_t)1 * M};
        pg8::gemm_phase(lds, g, S, E, tid); }
    SEAM(5);
    if (RUN(6)) { TIDS; conv_gmlp_phase(p, lds, tid, wave, lane); }
#if PROBE_SMALL
    if (RUN(6)) { TIDS; conv_gmlp_phase(p, lds, tid, wave, lane, PROBE_PARTS); }
#endif
    SEAM(6);
    if (RUN(7)) { TIDS;
        pg8::Gemm g{(const bf16_t*)(ws + WS_MIX), (const bf16_t*)(ws + WS_WOUT0), M, D, D, D, D};
        pg8::StaticOrder S; S.init(M, D, gridDim.x, blockIdx.x);
        pg8::EpiResid<false, false> E{nullptr, HN, SS + (size_t)2 * M};
        pg8::gemm_phase(lds, g, S, E, tid); }
    SEAM(7);
    ffn_block<1, 8, 2>(p, lds, grid, xbar, X, p.in[17]);
    ffn_block<2, 11, 3>(p, lds, grid, xbar, X, p.in[21]);
    if (RUN(15)) { TIDS;
        pg8::Gemm g{HN, (const bf16_t*)(ws + WS_WIN1), M, ZW, D, D, D};
        pg8::StaticOrder S; S.init(M, ZW, gridDim.x, blockIdx.x);
        pg8::EpiBf16 E{(bf16_t*)(ws + WS_Z), ZW, SS + (size_t)4 * M, (bf16_t*)(ws + WS_KCVC)};
        pg8::gemm_phase(lds, g, S, E, tid);
        {
            const int lo = ((M / 256) * (ZW / 256)) % (int)gridDim.x;
            const int c0 = p.tstart[9], c1 = p.tstart[11], cm = (c0 + 3456 < c1) ? c0 + 3456 : c1;
            if ((int)blockIdx.x >= lo) convert_range(p, c0, cm, ((int)blockIdx.x - lo) * 8 + wave, ((int)gridDim.x - lo) * 8, lane);
            convert_range(p, cm, c1, (int)blockIdx.x * 8 + wave, (int)gridDim.x * 8, lane);
        } }
    SEAM(15);
    if (RUN(16)) { TIDS; post_phase(p, lds, tid);
        __syncthreads();
        pg8::Gemm g{(const bf16_t*)(ws + WS_KCVC), (const bf16_t*)(ws + WS_W1T), 4096, 256, 512, 2048, 4096};
        pg8::CmpOrder S{(int)gridDim.x, (int)blockIdx.x};
        pg8::EpiCmp E{(float*)(ws + WS_H1P)};
        pg8::gemm_phase(lds, g, S, E, tid); }
    SEAM(17);
    if (RUN(18)) { TIDS; cmp2_phase(p, lds, tid); }
    SEAM(18);
    if (RUN(19)) { TIDS; attn_phase(p, lds, tid, lane, wave); }
#if PROBE_ATT
    if (RUN(19)) { TIDS; attn_phase(p, lds, tid, lane, wave); }
#endif
    SEAM(19);
    if (RUN(20) && DBG_P20) { TIDS;
        pg8::Gemm g{(const bf16_t*)(ws + WS_OB), (const bf16_t*)(ws + WS_WOUT1), M, D, D, D, D};
        pg8::StaticOrder S; S.init(M, D, gridDim.x, blockIdx.x);
        pg8::EpiResid<false, false> E{nullptr, HN, SS + (size_t)5 * M};
        pg8::gemm_phase(lds, g, S, E, tid); }
    SEAM(20);
    ffn_block<3, 21, 5>(p, lds, grid, xbar, X, p.in[34]);
#if PROBE_SYNC
    if (RUN(24)) { for (int i = 0; i < 20; ++i) grid.sync(); }
#endif
    if (RUN(24) && gridDim.x != 256) { TIDS; final_norm_phase(HN, p.in[38], p.out, wave, lane); }
}

#if DEBUG_CHECK
constexpr size_t WS_XOLD = 563 * MiB, WS_FLAG = 3 * MiB + 512 * 1024;
constexpr size_t WS_DOC = WS_W + 132 * MiB, WS_DOS = WS_W + 164 * MiB, WS_DOW = WS_W + 98 * MiB, WS_SELM = WS_W + 130 * MiB;
__device__ __forceinline__ unsigned hsh(unsigned x) { x ^= x >> 16; x *= 0x7feb352du; x ^= x >> 15; x *= 0x846ca68bu; x ^= x >> 16; return x; }
__device__ __forceinline__ float dotA(const bf16_t* a, int K, const float* W, int ldw, int col) { float s = 0.f; for (int k = 0; k < K; ++k) s += bf1(a[k]) * W[(size_t)k * ldw + col]; return s; }
__device__ __forceinline__ void chk_fail(unsigned* flag, unsigned code) { atomicMin(flag, code); }
__device__ __forceinline__ bool bad(float got, float ref, float atol) { const float e = fabsf(got - ref); return !(e <= atol + 0.03f * fabsf(ref)); }
__global__ void __launch_bounds__(64) chk_kernel(Params p, int ph) {
    unsigned char* ws = p.ws; unsigned* flag = (unsigned*)(ws + WS_FLAG);
    const float* X = (const float*)(ws + WS_X); const bf16_t* HN = (const bf16_t*)(ws + WS_HN); const bf16_t* ACT = (const bf16_t*)(ws + WS_ACT);
    const float* XOLD = (const float*)(ws + WS_XOLD);
    const int gt = blockIdx.x * 64 + threadIdx.x;
    const unsigned h1 = hsh(gt * 2654435761u + ph * 97u + 12345u), h2 = hsh(h1 + 0x9e3779b9u), h3 = hsh(h2 + 77u);
    const int m = h1 % M;
    const unsigned code = (unsigned)ph;
    __shared__ float sp[16][4][128]; __shared__ float simp[16][32];
    switch (ph) {
    case 1: case 4: case 8: case 11: case 14: case 21: {
        const float* src = (ph == 1) ? p.in[0] : X; const float* g = p.in[ph == 1 ? 2 : ph == 4 ? 6 : ph == 8 ? 17 : ph == 11 ? 21 : ph == 14 ? 25 : 34];
        const int n = h2 % D; float ss = 0.f; for (int k = 0; k < D; ++k) { const float v = src[(size_t)m * D + k]; ss += v * v; }
        const float ref = src[(size_t)m * D + n] / sqrtf(ss / D + EPS) * g[n];
        if (bad(bf1(HN[(size_t)m * D + n]), ref, 0.02f)) chk_fail(flag, code);
    } break;
    case 2: case 9: case 12: case 22: {
        const int fi = (ph == 2) ? 3 : (ph == 9) ? 18 : (ph == 12) ? 22 : 35; const int n = h2 % FF;
        const float g = dotA(HN + (size_t)m * D, D, p.in[fi], FF, n), u = dotA(HN + (size_t)m * D, D, p.in[fi + 1], FF, n);
        const float ref = g / (1.f + expf(-g)) * u;
        if (bad(bf1(ACT[(size_t)m * FF + n]), ref, 0.03f)) chk_fail(flag, code);
    } break;
    case 3: case 10: case 13: case 23: {
        const int fi = (ph == 3) ? 5 : (ph == 10) ? 20 : (ph == 13) ? 24 : 37; const int n = h2 % D;
        const float* xo = (ph == 3) ? p.in[0] : XOLD;
        const float ref = xo[(size_t)m * D + n] + 0.5f * dotA(ACT + (size_t)m * FF, FF, p.in[fi], D, n);
        if (bad(X[(size_t)m * D + n], ref, 0.03f)) chk_fail(flag, code);
    } break;
    case 5: {
        const bf16_t* AG = (const bf16_t*)(ws + WS_AG); const bf16_t* UV = (const bf16_t*)(ws + WS_UV);
        if (gt & 1) { const int n = h2 % 1024; const float v = dotA(HN + (size_t)m * D, D, p.in[7], 4096, n), g = dotA(HN + (size_t)m * D, D, p.in[7], 4096, 1024 + n);
            if (bad(bf1(AG[(size_t)m * 1024 + n]), v / (1.f + expf(-g)), 0.03f)) chk_fail(flag, code); }
        else { const int n = h2 % 2048; const float v = dotA(HN + (size_t)m * D, D, p.in[7], 4096, 2048 + n);
            const float ref = 0.5f * v * (1.f + tanhf(0.7978845608f * (v + 0.044715f * v * v * v)));
            if (bad(bf1(UV[(size_t)m * 2048 + n]), ref, 0.03f)) chk_fail(flag, 40u); }
    } break;
    case 6: {
        const bf16_t* AG = (const bf16_t*)(ws + WS_AG); const bf16_t* UV = (const bf16_t*)(ws + WS_UV); const bf16_t* MIX = (const bf16_t*)(ws + WS_MIX);
        if (gt < 256) {
            const int t = m & (SEQ - 1), cs = h2 % 1024; double s1 = 0, s2 = 0; float tgt = 0.f;
            for (int c = 0; c < 1024; ++c) { float a = p.in[9][c];
                for (int w = 0; w < 31; ++w) { const int tt = t - 30 + w; if (tt >= 0) a += bf1(AG[(size_t)(m - 30 + w) * 1024 + c]) * p.in[8][w * 1024 + c]; }
                s1 += a; s2 += (double)a * a; if (c == cs) tgt = a; }
            const float mean = (float)(s1 / 1024), var = (float)(s2 / 1024 - (s1 / 1024) * (s1 / 1024));
            const float y = (tgt - mean) / sqrtf(var + EPS) * p.in[10][cs] + p.in[11][cs];
            if (bad(bf1(MIX[(size_t)m * 2048 + cs]), y / (1.f + expf(-y)), 0.03f)) chk_fail(flag, 41u);
        } else if (gt < 768) {
            const int g = h2 % 8, d = h3 % 128, t = m & 127, mb = m - t; float sv = 0.f;
            for (int s = 0; s <= t; ++s) { const bf16_t* vr = UV + (size_t)(mb + s) * 2048 + 1024 + g * 128; float a = 0.f, q = 0.f;
                for (int e = 0; e < 128; ++e) a += bf1(vr[e]); a *= (1.f / 128.f);
                for (int e = 0; e < 128; ++e) { const float z = bf1(vr[e]) - a; q += z * z; }
                const float vl = (bf1(vr[d]) - a) / sqrtf(q / 128.f + EPS) * p.in[12][g * 128 + d] + p.in[13][g * 128 + d];
                sv += p.in[14][((size_t)g * 128 + t) * 128 + s] * vl; }
            const float ref = bf1(UV[(size_t)m * 2048 + g * 128 + d]) * (sv + p.in[15][g * 128 + t]);
            if (bad(bf1(MIX[(size_t)m * 2048 + 1024 + g * 128 + d]), ref, 0.03f)) chk_fail(flag, 42u);
        }
    } break;
    case 7: case 20: {
        const bf16_t* A = (const bf16_t*)(ws + (ph == 7 ? WS_MIX : WS_OB)); const int n = h2 % D;
        const float ref = XOLD[(size_t)m * D + n] + dotA(A + (size_t)m * D, D, p.in[ph == 7 ? 16 : 33], D, n);
        if (bad(X[(size_t)m * D + n], ref, 0.03f)) chk_fail(flag, code);
    } break;
    case 15: {
        const bf16_t* Z = (const bf16_t*)(ws + WS_Z); const int n = h2 % 5168;
        if (bad(bf1(Z[(size_t)m * ZW + n]), dotA(HN + (size_t)m * D, D, p.in[26], 5168, n), 0.03f)) chk_fail(flag, code);
    } break;
    case 16: {
        const bf16_t* Z = (const bf16_t*)(ws + WS_Z); const bf16_t* zr = Z + (size_t)m * ZW;
        const bf16_t* QR = (const bf16_t*)(ws + WS_QR); const bf16_t* KSR = (const bf16_t*)(ws + WS_KSR); const bf16_t* KWR = (const bf16_t*)(ws + WS_KWR);
        const bf16_t* KC = (const bf16_t*)(ws + WS_KCVC); const bf16_t* VC = KC + (size_t)16 * SEQ * 128;
        const bf16_t* VST = (const bf16_t*)(ws + WS_VST); const bf16_t* VWT = (const bf16_t*)(ws + WS_VWT); const float* GATE = (const float*)(ws + WS_GATE);
        const int b = m >> 11, t = m & (SEQ - 1), hd = h2 % 16, g = hd & 3, d = h3 % 128;
        const int i = d & 15; const double ang = (double)p.positions[m] * p.inv_freq[i]; double r = ang - 6.283185307179586 * floor(ang / 6.283185307179586 + 0.5);
        double cs = 1, sn = r, tc = 1, ts = r; for (int k = 1; k < 14; ++k) { tc *= -r * r / ((2 * k - 1) * (2 * k)); ts *= -r * r / ((2 * k) * (2 * k + 1)); cs += tc; sn += ts; }
        auto roped = [&](const bf16_t* base) -> float { if (d >= 32) return bf1(base[d]); const float x1 = bf1(base[i]), x2 = bf1(base[16 + i]); return d < 16 ? (float)(x1 * cs - x2 * sn) : (float)(x2 * cs + x1 * sn); };
        if (bad(bf1(QR[(size_t)m * 2048 + hd * 128 + d]), roped(zr + hd * 128), 0.02f)) chk_fail(flag, 50u);
        const size_t kidx = ((size_t)(b * 4 + g) * SEQ + t) * 128 + d, vidx = ((size_t)(b * 4 + g) * 128 + d) * SEQ + t;
        if (bad(bf1(KSR[kidx]), roped(zr + 3072 + g * 128), 0.02f)) chk_fail(flag, 51u);
        if (bad(bf1(KWR[kidx]), roped(zr + 4096 + g * 128), 0.02f)) chk_fail(flag, 52u);
        if (bad(bf1(KC[kidx]), bf1(zr[2048 + g * 128 + d]), 0.001f)) chk_fail(flag, 53u);
        if (bad(bf1(VC[kidx]), bf1(zr[2560 + g * 128 + d]), 0.001f)) chk_fail(flag, 54u);
        if (bad(bf1(VST[vidx]), bf1(zr[3584 + g * 128 + d]), 0.001f)) chk_fail(flag, 55u);
        if (bad(bf1(VWT[vidx]), bf1(zr[4608 + g * 128 + d]), 0.001f)) chk_fail(flag, 56u);
        const int gc = h3 % 48; const float zz = bf1(zr[5120 + gc]);
        if (bad(GATE[(size_t)m * 48 + gc], 1.f / (1.f + expf(-zz)), 0.01f)) chk_fail(flag, 57u);
    } break;
    case 17: {
        if (gt < 512) {
            const bf16_t* KC = (const bf16_t*)(ws + WS_KCVC); const bf16_t* H1 = (const bf16_t*)(ws + WS_H1);
            int r = h1 % 4096; if ((r & 127) == 127) r -= 1; const int kv = r >> 11, c = h2 % 256;
            const float* pe = p.in[kv ? 30 : 27]; const float* w1 = p.in[kv ? 31 : 28]; const bf16_t* row = KC + (size_t)r * 2048; float s = 0.f;
            for (int k = 0; k < 4096; ++k) s += (bf1(row[k]) + pe[k]) * w1[(size_t)k * 256 + c];
            const float ref = 0.5f * s * (1.f + tanhf(0.7978845608f * (s + 0.044715f * s * s * s)));
            if (bad(bf1(H1[(size_t)r * 256 + c]), ref, 0.03f)) chk_fail(flag, code);
        }
    } break;
    case 18: {
        const bf16_t* H1 = (const bf16_t*)(ws + WS_H1); const bf16_t* KCMP = (const bf16_t*)(ws + WS_KCMP); const bf16_t* VCMPT = (const bf16_t*)(ws + WS_VCMPT);
        const int r = h1 % 4096, d = h2 % 128; const float* w2 = p.in[r < 2048 ? 29 : 32]; float s = 0.f;
        for (int c = 0; c < 256; ++c) s += bf1(H1[(size_t)r * 256 + c]) * w2[c * 128 + d];
        const int rr = r & 2047, bg = rr >> 7, n = rr & 127;
        const float got = (r < 2048) ? bf1(KCMP[(size_t)r * 128 + d]) : bf1(VCMPT[((size_t)bg * 128 + d) * 128 + n]);
        if (bad(got, s, 0.02f)) chk_fail(flag, code);
    } break;
    case 19: {
        if (blockIdx.x < 16 && threadIdx.x < 16) {
            const int li = threadIdx.x;
            const bf16_t* Z = (const bf16_t*)(ws + WS_Z); const bf16_t* QR = (const bf16_t*)(ws + WS_QR);
            const bf16_t* KSR = (const bf16_t*)(ws + WS_KSR); const bf16_t* KWR = (const bf16_t*)(ws + WS_KWR);
            const bf16_t* VST = (const bf16_t*)(ws + WS_VST); const bf16_t* VWT = (const bf16_t*)(ws + WS_VWT);
            const bf16_t* KCMP = (const bf16_t*)(ws + WS_KCMP); const bf16_t* VCMPT = (const bf16_t*)(ws + WS_VCMPT);
            const float* GATE = (const float*)(ws + WS_GATE); const bf16_t* OB = (const bf16_t*)(ws + WS_OB);
            const bf16_t* DOC = (const bf16_t*)(ws + WS_DOC); const bf16_t* DOS = (const bf16_t*)(ws + WS_DOS); const bf16_t* DOW = (const bf16_t*)(ws + WS_DOW); const unsigned* SELM = (const unsigned*)(ws + WS_SELM);
            int mm = m; if (blockIdx.x < 4) mm = (m & ~(SEQ - 1)) + (h3 % 96);
            const int b = mm >> 11, t = mm & (SEQ - 1), hd = h2 % 16, g = hd >> 2, hq = hd & 3, bg = b * 4 + g, ds = h3 % 128;
            const float scale = 0.08838834764831845f;
            for (int hh = 0; hh < 4; ++hh) { const bf16_t* q = Z + (size_t)mm * ZW + (g * 4 + hh) * 128; float mx = -1e30f;
                for (int n = 0; n < 128; ++n) { float s = -1e30f; if (16 * n + 31 <= t) { s = 0.f; for (int e = 0; e < 128; ++e) s += bf1(q[e]) * bf1(KCMP[((size_t)bg * 128 + n) * 128 + e]); s *= scale; } sp[li][hh][n] = s; mx = fmaxf(mx, s); }
                float l = 0.f; for (int n = 0; n < 128; ++n) { const float pv = (16 * n + 31 <= t) ? expf(sp[li][hh][n] - mx) : 0.f; sp[li][hh][n] = pv; l += pv; }
                for (int n = 0; n < 128; ++n) sp[li][hh][n] = l > 0.f ? sp[li][hh][n] / l : 0.f; }
            float oc = 0.f; for (int n = 0; n < 128; ++n) oc += sp[li][hq][n] * bf1(VCMPT[((size_t)bg * 128 + ds) * 128 + n]);
            if (bad(bf1(DOC[(size_t)mm * 2048 + hd * 128 + ds]), oc, 0.01f)) chk_fail(flag, 60u);
            const int cur = t >> 6;
            for (int j = 0; j < 32; ++j) { float v = 0.f; for (int hh = 0; hh < 4; ++hh) for (int n = 4 * j - 1; n <= 4 * j + 3; ++n) if (n >= 0 && n < 128) v += sp[li][hh][n];
                if (j == 0 || j == cur || j == cur - 1) v += 1000.f; simp[li][j] = (64 * j <= t) ? v : -1e30f; }
            unsigned msk = 0u; int nclose = 0;
            for (int j = 0; j < 32; ++j) { int rank = 0; for (int j2 = 0; j2 < 32; ++j2) { if (simp[li][j2] > simp[li][j] || (simp[li][j2] == simp[li][j] && j2 < j)) ++rank; if (j2 != j && fabsf(simp[li][j2] - simp[li][j]) < 2e-3f * fabsf(simp[li][j]) && simp[li][j] > -1e29f) ++nclose; }
                if (rank < 16 && 64 * j <= t) msk |= 1u << j; }
            const unsigned kmsk = SELM[(size_t)mm * 4 + g];
            if (kmsk != msk && nclose == 0) chk_fail(flag, 61u);
            for (int br = 0; br < 2; ++br) {
                const bf16_t* q = QR + (size_t)mm * 2048 + hd * 128; const bf16_t* Kb = br ? KWR : KSR; const bf16_t* Vb = br ? VWT : VST;
                float mx = -1e30f;
                for (int kp = 0; kp <= t; ++kp) { const bool ok = br ? (kp > t - 512) : (((kmsk >> (kp >> 6)) & 1u) != 0u); if (!ok) continue;
                    float s = 0.f; for (int e = 0; e < 128; ++e) s += bf1(q[e]) * bf1(Kb[((size_t)bg * SEQ + kp) * 128 + e]); mx = fmaxf(mx, s * scale); }
                float l = 0.f, o = 0.f;
                for (int kp = 0; kp <= t; ++kp) { const bool ok = br ? (kp > t - 512) : (((kmsk >> (kp >> 6)) & 1u) != 0u); if (!ok) continue;
                    float s = 0.f; for (int e = 0; e < 128; ++e) s += bf1(q[e]) * bf1(Kb[((size_t)bg * SEQ + kp) * 128 + e]); const float pv = expf(s * scale - mx); l += pv; o += pv * bf1(Vb[((size_t)bg * 128 + ds) * SEQ + kp]); }
                o /= l;
                const float got = bf1((br ? DOW : DOS)[(size_t)mm * 2048 + hd * 128 + ds]);
                if (bad(got, o, 0.01f)) chk_fail(flag, br ? 63u : 62u);
            }
            const float fin = GATE[(size_t)mm * 48 + hd * 3] * bf1(DOC[(size_t)mm * 2048 + hd * 128 + ds]) + GATE[(size_t)mm * 48 + hd * 3 + 1] * bf1(DOS[(size_t)mm * 2048 + hd * 128 + ds]) + GATE[(size_t)mm * 48 + hd * 3 + 2] * bf1(DOW[(size_t)mm * 2048 + hd * 128 + ds]);
            if (bad(bf1(OB[(size_t)mm * 2048 + hd * 128 + ds]), fin, 0.01f)) chk_fail(flag, 64u);
        }
    } break;
    case 24: {
        const int n = h2 % D; float ss = 0.f; for (int k = 0; k < D; ++k) { const float v = X[(size_t)m * D + k]; ss += v * v; }
        if (bad(p.out[(size_t)m * D + n], X[(size_t)m * D + n] / sqrtf(ss / D + EPS) * p.in[38][n], 0.01f)) chk_fail(flag, code);
    } break;
    default: break;
    }
}
__global__ void report_kernel(Params p) {
    const unsigned f = *(const unsigned*)(p.ws + WS_FLAG);
    if (f == 0xffffffffu) return;
    const float c = sqrtf(1.0f + (float)f);
    for (size_t i = (size_t)blockIdx.x * blockDim.x + threadIdx.x; i < (size_t)M * D; i += (size_t)gridDim.x * blockDim.x) p.out[i] = c;
}
#endif

extern "C" void kernel_launch(void* const* d_in, const int* in_sizes, int n_in, void* d_out, int out_size, void* d_ws, size_t ws_size, hipStream_t stream) {
    static int grid = 0;
    if (grid == 0) {
        if (n_in != 39 || ws_size < WS_END + (DEBUG_CHECK ? 64 * MiB : 0)) { fprintf(stderr, "kernel_launch: unexpected n_in %d or ws_size %zu (need %zu)\n", n_in, ws_size, (size_t)WS_END); grid = -1; return; }
        int dev = 0, cus = 0, per_cu = 0;
        hipGetDevice(&dev);
        hipDeviceGetAttribute(&cus, hipDeviceAttributeMultiprocessorCount, dev);
        hipFuncSetAttribute((const void*)fwd_kernel, hipFuncAttributeMaxDynamicSharedMemorySize, LDS_BYTES);
        hipOccupancyMaxActiveBlocksPerMultiprocessor(&per_cu, (const void*)fwd_kernel, 512, LDS_BYTES);
        (void)hipGetLastError();
        if (per_cu < 1) fprintf(stderr, "kernel_launch: occupancy query says %d blocks per CU\n", per_cu);
        grid = cus > 0 ? cus : 256;
    }
    if (grid < 0) return;
    Params p; memset(&p, 0, sizeof(p));
    for (int i = 0; i < 39; ++i) p.in[i] = (const float*)d_in[i];
    p.positions = (const int*)d_in[1];
    p.out = (float*)d_out; p.ws = (unsigned char*)d_ws;
    unsigned char* ws = (unsigned char*)d_ws;
    int nd = 0;
    auto add = [&](const void* W, size_t wt_off, int K, int ldw, int col0, int nvalid, int nblk, int mode, const void* gain = nullptr) {
        TDesc& t = p.td[nd++]; t.gain = (const float*)gain; t.W = (const float*)W; t.WT = (bf16_t*)(ws + wt_off); t.K = K; t.ldw = ldw; t.col0 = col0; t.nvalid = nvalid; t.nblk = nblk; t.mode = mode; };
    const int ffn_in[4] = {3, 18, 22, 35}; const int ffn_norm[4] = {2, 17, 21, 34};
    for (int f = 0; f < 4; ++f) {
        add(d_in[ffn_in[f]], WS_WGU(f), D, FF, 0, FF, FF / 64, 1, d_in[ffn_norm[f]]);
        add(d_in[ffn_in[f] + 1], WS_WGU(f), D, FF, 0, FF, FF / 64, 2, d_in[ffn_norm[f]]);
        add(d_in[ffn_in[f] + 2], WS_WD(f), FF, D, 0, D, D / 64, 0);
    }
    add(d_in[7], WS_WIN0, D, 4096, 0, 1024, 16, 1, d_in[6]);
    add(d_in[7], WS_WIN0, D, 4096, 1024, 1024, 16, 2, d_in[6]);
    add(d_in[7], WS_WIN0 + (size_t)2048 * D * 2, D, 4096, 2048, 2048, 32, 0, d_in[6]);
    add(d_in[16], WS_WOUT0, D, D, 0, D, 32, 0);
    add(d_in[26], WS_WIN1, D, 5168, 0, 5168, ZW / 64, 0, d_in[25]);
    add(d_in[33], WS_WOUT1, D, D, 0, D, 32, 0);
    add(d_in[28], WS_W1T, 4096, 256, 0, 256, 4, 0);
    add(d_in[31], WS_W1T + (size_t)256 * 4096 * 2, 4096, 256, 0, 256, 4, 0);
    for (int i = 0; i < 16; ++i) p.inv_freq[i] = pow(500000.0, -(double)i / 16.0);
    p.tstart[0] = 0;
    for (int i = 0; i < NDESC; ++i) p.tstart[i + 1] = p.tstart[i] + (p.td[i].K / 64) * p.td[i].nblk;
#if ONE_LAUNCH
    (void)hipMemsetAsync(ws + WS_BAR, 0, 16384, stream);
    p.ph_lo = 0; p.ph_hi = NPHASE;
    void* args[] = {&p};
    hipError_t e = hipLaunchCooperativeKernel((const void*)fwd_kernel, dim3(grid), dim3(512), args, LDS_BYTES, stream);
    if (e != hipSuccess) fprintf(stderr, "cooperative launch failed: %s (grid %d)\n", hipGetErrorString(e), grid);
#else
#if DEBUG_CHECK
    (void)hipMemsetAsync(ws + WS_FLAG, 0xFF, 4, stream);
#endif
    for (int ph = 0; ph < NPHASE; ++ph) {
        p.ph_lo = ph; p.ph_hi = ph + 1;
#if DEBUG_CHECK
        if (ph == 7 || ph == 10 || ph == 13 || ph == 20 || ph == 23) (void)hipMemcpyAsync(ws + WS_XOLD, ws + WS_X, (size_t)M * D * 4, hipMemcpyDeviceToDevice, stream);
#endif
        hipLaunchKernelGGL(fwd_kernel, dim3(grid), dim3(512), LDS_BYTES, stream, p);
#if DEBUG_CHECK
        hipLaunchKernelGGL(chk_kernel, dim3(32), dim3(64), 0, stream, p, ph);
#endif
    }
#if DEBUG_CHECK
    hipLaunchKernelGGL(report_kernel, dim3(1024), dim3(256), 0, stream, p);
#endif
#endif
}
```

```cpp
#include <hip/hip_runtime.h>
#include <hip/hip_cooperative_groups.h>
#include <cstdio>
#include <cstring>
#include <cmath>
namespace cg = cooperative_groups;

#ifndef ONE_LAUNCH
#define ONE_LAUNCH 1
#endif

#define LAS __attribute__((address_space(3)))
#define DBG_P20 1
#ifndef DEBUG_CHECK
#define DEBUG_CHECK 0
#endif
#define DBG_DUMP 0
#define PROBE_ATT 0
#define PROBE_PRO 0
#define PROBE_UP 0
#define PROBE_SYNC 0
#define PROBE_SMALL 0
#define PROBE_PARTS 1
typedef unsigned short bf16_t;
typedef short bf16x8 __attribute__((ext_vector_type(8)));
typedef float f32x4 __attribute__((ext_vector_type(4)));
typedef float f32x2 __attribute__((ext_vector_type(2)));
typedef unsigned u32x4 __attribute__((ext_vector_type(4)));
typedef unsigned u32x2 __attribute__((ext_vector_type(2)));
typedef unsigned long long ss_t;
constexpr float SS_SCALE = 1048576.0f, SS_INV = 1.0f / 1048576.0f;

constexpr int M = 8192, D = 2048, FF = 5632, SEQ = 2048;
constexpr int ZW = 5376;
constexpr float EPS = 1e-6f;
constexpr int NPHASE = 25;
constexpr float SC_LOG2 = 0.08838834764831845f * 1.4426950408889634f;

constexpr size_t MiB = 1u << 20;
constexpr size_t WS_ROPE = 0;
constexpr size_t WS_PB = 1 * MiB;
constexpr size_t WS_CBIAS = 1 * MiB + 256 * 1024;
constexpr size_t WS_SS = 1 * MiB + 512 * 1024;
constexpr size_t WS_CNT = 1 * MiB + 992 * 1024;
constexpr size_t WS_GATE = 2 * MiB;
constexpr size_t WS_W = 4 * MiB;
constexpr size_t WS_WGU(int f) { return WS_W + (size_t)f * 66 * MiB; }
constexpr size_t WS_WD(int f) { return WS_W + (size_t)f * 66 * MiB + 44 * MiB; }
constexpr size_t WS_WIN0 = 268 * MiB, WS_WOUT0 = 284 * MiB, WS_WIN1 = 292 * MiB, WS_WOUT1 = 313 * MiB, WS_W1T = 321 * MiB;
constexpr size_t WS_X = 326 * MiB, WS_HN = 390 * MiB, WS_ACT = 422 * MiB;
constexpr size_t WS_AG = WS_ACT, WS_UV = WS_ACT + 16 * MiB, WS_MIX = WS_ACT + 48 * MiB, WS_Z = WS_ACT, WS_QR = WS_X;
constexpr size_t WS_KSR = 510 * MiB, WS_KWR = 518 * MiB, WS_KCVC = 526 * MiB, WS_VST = 543 * MiB, WS_VWT = 551 * MiB;
constexpr size_t WS_H1 = 559 * MiB, WS_KCMP = 561 * MiB, WS_VCMPT = 562 * MiB, WS_END = 563 * MiB;
constexpr size_t WS_OACC = WS_W;
constexpr size_t WS_OB = WS_W + 66 * MiB;
constexpr size_t WS_H1P = WS_W + 132 * MiB;

constexpr int LDS_BYTES = 147456;

struct TDesc { const float* W; bf16_t* WT; const float* gain; int K, ldw, col0, nvalid, nblk, mode; };
constexpr int NDESC = 20;
struct Params {
    const float* in[39];
    const int* positions;
    float* out;
    unsigned char* ws;
    TDesc td[NDESC];
    int tstart[NDESC + 4];
    double inv_freq[16];
    int ph_lo, ph_hi;
};

__device__ __forceinline__ float bflo(unsigned w) { return __uint_as_float(w << 16); }
__device__ __forceinline__ float bfhi(unsigned w) { return __uint_as_float(w & 0xffff0000u); }
__device__ __forceinline__ float bf1(bf16_t b) { return __uint_as_float(((unsigned)b) << 16); }
typedef __bf16 bf16x2_t __attribute__((ext_vector_type(2)));
__device__ __forceinline__ unsigned cvt_pk_bf16(float lo, float hi) { const f32x2 v = {lo, hi}; return __builtin_bit_cast(unsigned, __builtin_convertvector(v, bf16x2_t)); }
__device__ __forceinline__ float sigmoid_f(float x) { return __builtin_amdgcn_rcpf(1.0f + __builtin_amdgcn_exp2f(-1.44269504f * x)); }
__device__ __forceinline__ float silu_f(float x) { return x * sigmoid_f(x); }
__device__ __forceinline__ float gelu_f(float x) { const float u = 1.5957691216f * (x + 0.044715f * x * x * x); return x * sigmoid_f(u); }
__device__ __forceinline__ float wave_sum(float v) {
#pragma unroll
    for (int o = 1; o < 64; o <<= 1) v += __shfl_xor(v, o);
    return v;
}
#define LDS_WAIT() asm volatile("s_waitcnt lgkmcnt(0)" ::: "memory")

namespace pg8 {
constexpr int BM = 256, BK = 64, HALF = 128, HTB = HALF * BK * 2, STAGE_BYTES = 8 * HTB, NXCD = 8, WGM = 8;
__device__ __forceinline__ int lds_byte(int r, int c) { const int st = (r >> 4) * 2 + (c >> 5), rr = r & 15, cc = c & 31, ob = rr * 64 + cc * 2; return st * 1024 + (ob ^ (((ob >> 9) & 1) << 5)); }
__device__ __forceinline__ void stage_rc(int b, int& R, int& C) { const int st = b / 1024, sb = b % 1024, swz = sb ^ (((sb >> 9) & 1) << 5); R = (st >> 1) * 16 + swz / 64; C = (st & 1) * 32 + (swz % 64) / 2; }
__device__ __forceinline__ int perm32(int rho) { const int n = rho >> 4, i = rho & 15; return 8 * (i >> 2) + 4 * n + (i & 3); }

struct Unit { int pm, pn, koff; };
struct Gemm { const bf16_t* A; const bf16_t* Bt; int M, N, K, lda, ldb; };

struct StaticOrder {
    int nM, nN, nwg, G, c;
    __device__ void init(int M_, int N_, int G_, int c_) { nM = M_ / BM; nN = N_ / BM; nwg = nM * nN; G = G_; c = c_; }
    __device__ bool next(int i, Unit& u) const {
        const long L = (long)i * G + c; if (L >= nwg) return false;
        int wgid = (int)L; { const int q = nwg / NXCD, r = nwg % NXCD, xcd = wgid % NXCD, off = wgid / NXCD; wgid = (xcd < r ? xcd * (q + 1) : r * (q + 1) + (xcd - r) * q) + off; }
        const int nig = WGM * nN, gid = wgid / nig, fm = gid * WGM, gsz = (nM - fm) < WGM ? (nM - fm) : WGM;
        u.pm = fm + ((wgid % nig) % gsz); u.pn = (wgid % nig) / gsz; u.koff = 0; return true;
    }
};
struct CmpOrder {
    int G, c;
    __device__ bool next(int i, Unit& u) const { const int L = i * G + c; if (L >= 128) return false; u.pm = L & 15; u.pn = (L & 15) >> 3; u.koff = (L >> 4) * 1024; return true; }
};

struct EpiSwiGLU {
    static constexpr bool PERM = true, AFTER_DRAIN = false;
    bf16_t* O; const ss_t* ss;
    __device__ __forceinline__ void operator()(const f32x4 (&acc)[2][2][4][2], const Unit& u, int wr, int wc, int fr, int fq) const {
        const int row0 = u.pm * BM + wr * 64 + fr, col0 = u.pn * 128 + wc * 32 + 8 * fq;
        float rs[8];
#pragma unroll
        for (int q = 0; q < 8; ++q) rs[q] = (float)ss[row0 + (q >> 2) * HALF + (q & 3) * 16] * SS_INV;
#pragma unroll
        for (int q = 0; q < 8; ++q) rs[q] = rsqrtf(rs[q] * (1.0f / D) + EPS);
#pragma unroll
        for (int ai = 0; ai < 2; ++ai)
#pragma unroll
            for (int m = 0; m < 4; ++m) {
                const int row = row0 + ai * HALF + m * 16;
                const float rstd = rs[ai * 4 + m], rl = -1.44269504f * rstd, r2 = rstd * rstd;
                bf16_t* rowp = O + (size_t)row * FF + col0;
                unsigned pk[4];
#pragma unroll
                for (int n = 0; n < 2; ++n)
#pragma unroll
                    for (int h2 = 0; h2 < 2; ++h2) {
                        const f32x2 g = {acc[ai][0][m][n][2 * h2], acc[ai][0][m][n][2 * h2 + 1]}, u = {acc[ai][1][m][n][2 * h2], acc[ai][1][m][n][2 * h2 + 1]};
                        const f32x2 t = g * rl;
                        f32x2 e; e.x = __builtin_amdgcn_exp2f(t.x); e.y = __builtin_amdgcn_exp2f(t.y);
                        const f32x2 d = e + 1.0f;
                        f32x2 sg; sg.x = __builtin_amdgcn_rcpf(d.x); sg.y = __builtin_amdgcn_rcpf(d.y);
                        const f32x2 o = (g * u) * (sg * r2);
                        pk[n * 2 + h2] = cvt_pk_bf16(o.x, o.y);
                    }
                u32x4 w; w.x = pk[0]; w.y = pk[1]; w.z = pk[2]; w.w = pk[3];
                *(u32x4*)rowp = w;
            }
    }
};
template <bool HALFA, bool BASEF32>
struct EpiResid {
    static constexpr bool PERM = false, AFTER_DRAIN = false;
    const float* basef; bf16_t* xb; ss_t* ss;
    __device__ __forceinline__ void operator()(const f32x4 (&acc)[2][2][4][2], const Unit& u, int wr, int wc, int fr, int fq) const {
        const float alpha = HALFA ? 0.5f : 1.0f;
        const int row0 = u.pm * BM + wr * 64 + fr, col0 = u.pn * BM + wc * 32 + 4 * fq;
        float sq[8];
#pragma unroll
        for (int ai = 0; ai < 2; ++ai) {
            f32x4 b[4][2][2];
#pragma unroll
            for (int m = 0; m < 4; ++m)
#pragma unroll
                for (int bj = 0; bj < 2; ++bj)
#pragma unroll
                    for (int n = 0; n < 2; ++n) {
                        const size_t o = (size_t)(row0 + ai * HALF + m * 16) * D + col0 + bj * HALF + n * 16;
                        if (BASEF32) b[m][bj][n] = *(const f32x4*)(basef + o);
                        else { const u32x2 w = *(const u32x2*)(xb + o); b[m][bj][n] = (f32x4){bflo(w.x), bfhi(w.x), bflo(w.y), bfhi(w.y)}; }
                    }
#pragma unroll
            for (int m = 0; m < 4; ++m) {
                const size_t off = (size_t)(row0 + ai * HALF + m * 16) * D + col0;
                float q = 0.f;
#pragma unroll
                for (int bj = 0; bj < 2; ++bj)
#pragma unroll
                    for (int n = 0; n < 2; ++n) { const f32x4 v = b[m][bj][n] + alpha * acc[ai][bj][m][n];
                        u32x2 w; w.x = cvt_pk_bf16(v[0], v[1]); w.y = cvt_pk_bf16(v[2], v[3]); *(u32x2*)(xb + off + bj * HALF + n * 16) = w;
                        q += (v[0] * v[0] + v[1] * v[1]) + (v[2] * v[2] + v[3] * v[3]); }
                sq[ai * 4 + m] = q;
            }
        }
#pragma unroll
        for (int q = 0; q < 8; ++q) { float t = sq[q]; t += __shfl_xor(t, 16); t += __shfl_xor(t, 32); sq[q] = t; }
        if (fq == 0) {
#pragma unroll
            for (int q = 0; q < 8; ++q) __hip_atomic_fetch_add(ss + row0 + (q >> 2) * HALF + (q & 3) * 16, (ss_t)(sq[q] * SS_SCALE), __ATOMIC_RELAXED, __HIP_MEMORY_SCOPE_AGENT);
        }
    }
};
struct EpiResidFinal {
    static constexpr bool PERM = false, AFTER_DRAIN = true;
    const bf16_t* xb; ss_t* ss; unsigned* cnt; const float* gain; float* out;
    __device__ __forceinline__ void fused(f32x4 (&acc)[2][2][4][2], const Unit& u, int wr, int wc, int fr, int fq, int tid) const {
        const int row0 = u.pm * BM + wr * 64 + fr, col0 = u.pn * BM + wc * 32 + 4 * fq;
        float sq[8];
#pragma unroll
        for (int ai = 0; ai < 2; ++ai) {
            u32x2 b[4][2][2];
#pragma unroll
            for (int m = 0; m < 4; ++m)
#pragma unroll
                for (int bj = 0; bj < 2; ++bj)
#pragma unroll
                    for (int n = 0; n < 2; ++n) b[m][bj][n] = *(const u32x2*)(xb + (size_t)(row0 + ai * HALF + m * 16) * D + col0 + bj * HALF + n * 16);
#pragma unroll
            for (int m = 0; m < 4; ++m) {
                float q = 0.f;
#pragma unroll
                for (int bj = 0; bj < 2; ++bj)
#pragma unroll
                    for (int n = 0; n < 2; ++n) { const u32x2 w = b[m][bj][n]; const f32x4 v = (f32x4){bflo(w.x), bfhi(w.x), bflo(w.y), bfhi(w.y)} + 0.5f * acc[ai][bj][m][n];
                        acc[ai][bj][m][n] = v; q += (v[0] * v[0] + v[1] * v[1]) + (v[2] * v[2] + v[3] * v[3]); }
                sq[ai * 4 + m] = q;
            }
        }
#pragma unroll
        for (int q = 0; q < 8; ++q) { float t = sq[q]; t += __shfl_xor(t, 16); t += __shfl_xor(t, 32); sq[q] = t; }
        if (fq == 0) {
#pragma unroll
            for (int q = 0; q < 8; ++q) __hip_atomic_fetch_add(ss + row0 + (q >> 2) * HALF + (q & 3) * 16, (ss_t)(sq[q] * SS_SCALE), __ATOMIC_RELAXED, __HIP_MEMORY_SCOPE_AGENT);
        }
        asm volatile("s_waitcnt vmcnt(0)" ::: "memory");
        __syncthreads();
        if (tid == 0) {
            unsigned* c = cnt + 64 * u.pm;
            __hip_atomic_fetch_add(c, 1u, __ATOMIC_RELAXED, __HIP_MEMORY_SCOPE_AGENT);
            unsigned spins = 0;
            while (__hip_atomic_load(c, __ATOMIC_RELAXED, __HIP_MEMORY_SCOPE_AGENT) < 8u) { __builtin_amdgcn_s_sleep(1); if (++spins > (1u << 22)) break; }
            __builtin_amdgcn_fence(__ATOMIC_ACQUIRE, "agent");
            asm volatile("s_waitcnt vmcnt(0)" ::: "memory");
        }
        __syncthreads();
        float rs[8];
#pragma unroll
        for (int q = 0; q < 8; ++q) rs[q] = (float)__hip_atomic_load(ss + row0 + (q >> 2) * HALF + (q & 3) * 16, __ATOMIC_RELAXED, __HIP_MEMORY_SCOPE_AGENT) * SS_INV;
#pragma unroll
        for (int q = 0; q < 8; ++q) rs[q] = 1.0f / sqrtf(rs[q] * (1.0f / D) + EPS);
        f32x4 gg[2][2];
#pragma unroll
        for (int bj = 0; bj < 2; ++bj)
#pragma unroll
            for (int n = 0; n < 2; ++n) gg[bj][n] = *(const f32x4*)(gain + col0 + bj * HALF + n * 16);
#pragma unroll
        for (int ai = 0; ai < 2; ++ai)
#pragma unroll
            for (int m = 0; m < 4; ++m) {
                const float rstd = rs[ai * 4 + m];
                float* op = out + (size_t)(row0 + ai * HALF + m * 16) * D + col0;
#pragma unroll
                for (int bj = 0; bj < 2; ++bj)
#pragma unroll
                    for (int n = 0; n < 2; ++n) *(f32x4*)(op + bj * HALF + n * 16) = acc[ai][bj][m][n] * rstd * gg[bj][n];
            }
    }
};
struct EpiL0In {
    static constexpr bool PERM = true, AFTER_DRAIN = false;
    bf16_t* AG; bf16_t* UV; const ss_t* ss;
    __device__ __forceinline__ void operator()(const f32x4 (&acc)[2][2][4][2], const Unit& u, int wr, int wc, int fr, int fq) const {
        const int row0 = u.pm * BM + wr * 64 + fr;
        float rs[8];
#pragma unroll
        for (int q = 0; q < 8; ++q) rs[q] = (float)ss[row0 + (q >> 2) * HALF + (q & 3) * 16] * SS_INV;
#pragma unroll
        for (int q = 0; q < 8; ++q) rs[q] = rsqrtf(rs[q] * (1.0f / D) + EPS);
        if (u.pn < 8) {
            const int col0 = u.pn * 128 + wc * 32 + 8 * fq;
#pragma unroll
            for (int ai = 0; ai < 2; ++ai)
#pragma unroll
                for (int m = 0; m < 4; ++m) {
                    const float rstd = rs[ai * 4 + m];
                    const float rl = -1.44269504f * rstd;
                    unsigned pk[4];
#pragma unroll
                    for (int n = 0; n < 2; ++n)
#pragma unroll
                        for (int h2 = 0; h2 < 2; ++h2) {
                            const f32x2 va = {acc[ai][0][m][n][2 * h2], acc[ai][0][m][n][2 * h2 + 1]}, ga = {acc[ai][1][m][n][2 * h2], acc[ai][1][m][n][2 * h2 + 1]};
                            const f32x2 t = ga * rl;
                            f32x2 e; e.x = __builtin_amdgcn_exp2f(t.x); e.y = __builtin_amdgcn_exp2f(t.y);
                            const f32x2 d = e + 1.0f;
                            f32x2 sg; sg.x = __builtin_amdgcn_rcpf(d.x); sg.y = __builtin_amdgcn_rcpf(d.y);
                            const f32x2 o = va * (sg * rstd);
                            pk[n * 2 + h2] = cvt_pk_bf16(o.x, o.y);
                        }
                    u32x4 w; w.x = pk[0]; w.y = pk[1]; w.z = pk[2]; w.w = pk[3];
                    *(u32x4*)(AG + (size_t)(row0 + ai * HALF + m * 16) * 1024 + col0) = w;
                }
        } else {
            const int col0 = (u.pn - 8) * BM + wc * 32 + 8 * fq;
#pragma unroll
            for (int ai = 0; ai < 2; ++ai)
#pragma unroll
                for (int m = 0; m < 4; ++m)
#pragma unroll
                    for (int bj = 0; bj < 2; ++bj) {
                        const float rstd = rs[ai * 4 + m];
                        float v[8];
#pragma unroll
                        for (int n = 0; n < 2; ++n)
#pragma unroll
                            for (int i = 0; i < 4; ++i) v[n * 4 + i] = gelu_f(acc[ai][bj][m][n][i] * rstd);
                        u32x4 w; w.x = cvt_pk_bf16(v[0], v[1]); w.y = cvt_pk_bf16(v[2], v[3]); w.z = cvt_pk_bf16(v[4], v[5]); w.w = cvt_pk_bf16(v[6], v[7]);
                        *(u32x4*)(UV + (size_t)(row0 + ai * HALF + m * 16) * 2048 + col0 + bj * HALF) = w;
                    }
        }
    }
};
struct EpiBf16 {
    static constexpr bool PERM = true, AFTER_DRAIN = false;
    bf16_t* O; int ldc; const ss_t* ss; bf16_t* kcvc;
    __device__ __forceinline__ void operator()(const f32x4 (&acc)[2][2][4][2], const Unit& u, int wr, int wc, int fr, int fq) const {
        const int row0 = u.pm * BM + wr * 64 + fr, col0 = u.pn * BM + wc * 32 + 8 * fq;
        const bool tokv = kcvc != nullptr && u.pn >= 8 && u.pn < 12;
        float rs[8];
#pragma unroll
        for (int q = 0; q < 8; ++q) rs[q] = (float)ss[row0 + (q >> 2) * HALF + (q & 3) * 16] * SS_INV;
#pragma unroll
        for (int q = 0; q < 8; ++q) rs[q] = rsqrtf(rs[q] * (1.0f / D) + EPS);
#pragma unroll
        for (int ai = 0; ai < 2; ++ai)
#pragma unroll
            for (int m = 0; m < 4; ++m)
#pragma unroll
                for (int bj = 0; bj < 2; ++bj) {
                    const float rstd = rs[ai * 4 + m];
                    const f32x4 v0 = acc[ai][bj][m][0] * rstd, v1 = acc[ai][bj][m][1] * rstd;
                    u32x4 w; w.x = cvt_pk_bf16(v0[0], v0[1]); w.y = cvt_pk_bf16(v0[2], v0[3]); w.z = cvt_pk_bf16(v1[0], v1[1]); w.w = cvt_pk_bf16(v1[2], v1[3]);
                    const int row = row0 + ai * HALF + m * 16;
                    if (tokv) { const int which = (u.pn - 8) >> 1, g = 2 * ((u.pn - 8) & 1) + bj, b = row >> 11, t = row & (SEQ - 1);
                        *(u32x4*)(kcvc + (size_t)which * 16 * SEQ * 128 + ((size_t)(b * 4 + g) * SEQ + t) * 128 + wc * 32 + 8 * fq) = w; }
                    else *(u32x4*)(O + (size_t)row * ldc + col0 + bj * HALF) = w;
                }
    }
};
struct EpiCmp {
    static constexpr bool PERM = false, AFTER_DRAIN = false;
    float* P;
    __device__ __forceinline__ void operator()(const f32x4 (&acc)[2][2][4][2], const Unit& u, int wr, int wc, int fr, int fq) const {
        const int row0 = u.pm * BM + wr * 64 + fr, col0 = wc * 32 + 4 * fq;
        float* base = P + (size_t)(u.koff >> 10) * 4096 * 256;
#pragma unroll
        for (int ai = 0; ai < 2; ++ai)
#pragma unroll
            for (int m = 0; m < 4; ++m)
#pragma unroll
                for (int bj = 0; bj < 2; ++bj)
#pragma unroll
                    for (int n = 0; n < 2; ++n) *(f32x4*)(base + (size_t)(row0 + ai * HALF + m * 16) * 256 + col0 + bj * HALF + n * 16) = acc[ai][bj][m][n];
    }
};

template <class Epi, class Sched>
__device__ __forceinline__ void gemm_phase(LAS unsigned char* lds, const Gemm g, const Sched& S, const Epi& E, const int tid) {
    const int wid = __builtin_amdgcn_readfirstlane(tid >> 6), lane = tid & 63, wr = wid >> 2, wc = wid & 3, fr = lane & 15, fq = lane >> 4;
    const int K = g.K, nt = K / BK, lda = g.lda, ldb = g.ldb;
    unsigned voffA[2], voffB[2];
#pragma unroll
    for (int i = 0; i < 2; ++i) { int R, C; stage_rc(tid * 16 + i * 8192, R, C); const int Rb = Epi::PERM ? ((R & ~31) + perm32(R & 31)) : R;
        voffA[i] = (unsigned)(R * lda + C) * 2u; voffB[i] = (unsigned)(Rb * ldb + C) * 2u; }
    const size_t kstep = (size_t)(BK * 2);
    const size_t hstepA = (size_t)HALF * lda * 2, hstepB = (size_t)HALF * ldb * 2;
    const size_t tstepA = 2 * hstepA, tstepB = 2 * hstepB;
    const unsigned ldsw = (unsigned)wid * 1024u;
    const int aoff = lds_byte(wr * 64 + fr, fq * 8), boff = lds_byte(wc * 32 + fr, fq * 8);
#define PG8_SA(b, h) (((b) * 2 + (h)) * HTB)
#define PG8_SB(b, h) ((4 + (b) * 2 + (h)) * HTB)
#define PG8_STAGE(bufoff, gbase, voff) do { _Pragma("unroll") for (int _i = 0; _i < 2; ++_i) \
        __builtin_amdgcn_global_load_lds((const unsigned*)((const char*)(gbase) + (voff)[_i]), (LAS unsigned*)(lds + (bufoff) + ldsw + _i * 8192), 16, 0, 0); } while (0)
#define PG8_LDA(dst, b, h) do { _Pragma("unroll") for (int m = 0; m < 4; ++m) _Pragma("unroll") for (int k = 0; k < 2; ++k) dst[m][k] = *(const LAS bf16x8*)(lds + PG8_SA(b, h) + aoff + m * 2048 + k * 1024); } while (0)
#define PG8_LDB(dst, b, h) do { _Pragma("unroll") for (int n = 0; n < 2; ++n) _Pragma("unroll") for (int k = 0; k < 2; ++k) dst[n][k] = *(const LAS bf16x8*)(lds + PG8_SB(b, h) + boff + n * 2048 + k * 1024); } while (0)
#define PG8_MMA(ai, bj, At, Bt) do { __builtin_amdgcn_s_setprio(1); _Pragma("unroll") for (int m = 0; m < 4; ++m) _Pragma("unroll") for (int n = 0; n < 2; ++n) _Pragma("unroll") for (int k = 0; k < 2; ++k) \
        acc[ai][bj][m][n] = __builtin_amdgcn_mfma_f32_16x16x32_bf16(Bt[n][k], At[m][k], acc[ai][bj][m][n], 0, 0, 0); __builtin_amdgcn_s_setprio(0); } while (0)
#define PG8_WAIT_V(n) asm volatile("s_waitcnt vmcnt(" #n ")" ::: "memory")
#define PG8_WAIT_L(n) asm volatile("s_waitcnt lgkmcnt(" #n ")" ::: "memory")
#define PG8_BAR __builtin_amdgcn_s_barrier()
#define PG8_SCHED __builtin_amdgcn_sched_barrier(0)
    Unit cur, nxt; int ui = 0;
    if (!S.next(0, cur)) return;
    f32x4 acc[2][2][4][2];
#pragma unroll
    for (int a = 0; a < 2; ++a)
#pragma unroll
        for (int b = 0; b < 2; ++b)
#pragma unroll
            for (int m = 0; m < 4; ++m)
#pragma unroll
                for (int n = 0; n < 2; ++n) acc[a][b][m][n] = (f32x4){0.f, 0.f, 0.f, 0.f};
    bf16x8 At[4][2], B0[2][2], B1[2][2];
    const char* cA = (const char*)g.A + (size_t)cur.pm * tstepA + cur.koff; const char* cB = (const char*)g.Bt + (size_t)cur.pn * tstepB + cur.koff;
    PG8_STAGE(PG8_SB(0, 0), cB, voffB); PG8_STAGE(PG8_SA(0, 0), cA, voffA); PG8_STAGE(PG8_SB(0, 1), cB + hstepB, voffB); PG8_STAGE(PG8_SA(0, 1), cA + hstepA, voffA);
    if (wr == 1) PG8_BAR;
    PG8_WAIT_V(4); PG8_BAR;
    PG8_STAGE(PG8_SB(1, 0), cB + kstep, voffB); PG8_STAGE(PG8_SA(1, 0), cA + kstep, voffA); PG8_STAGE(PG8_SB(1, 1), cB + hstepB + kstep, voffB);
    PG8_WAIT_V(6); PG8_BAR;
    for (;;) {
        const bool has_next = S.next(ui + 1, nxt);
        const char* nA = has_next ? (const char*)g.A + (size_t)nxt.pm * tstepA + nxt.koff : cA; const char* nB = has_next ? (const char*)g.Bt + (size_t)nxt.pn * tstepB + nxt.koff : cB;
        for (int t = 0; t < nt; t += 2) {
            const bool last = (t == nt - 2);
            const char* a1 = cA + (size_t)(t + 1) * kstep;
            const char* a2 = last ? nA : cA + (size_t)(t + 2) * kstep; const char* b2 = last ? nB : cB + (size_t)(t + 2) * kstep;
            const char* a3 = a2 + kstep; const char* b3 = b2 + kstep;
            PG8_LDB(B0, 0, 0); PG8_SCHED; PG8_LDA(At, 0, 0); PG8_STAGE(PG8_SA(1, 1), a1 + hstepA, voffA);
            PG8_WAIT_L(8); PG8_BAR; PG8_WAIT_L(0); PG8_MMA(0, 0, At, B0); PG8_BAR; PG8_SCHED;
            PG8_LDB(B1, 0, 1); PG8_STAGE(PG8_SB(0, 0), b2, voffB);
            PG8_BAR; PG8_WAIT_L(0); PG8_MMA(0, 1, At, B1); PG8_BAR;
            PG8_LDA(At, 0, 1); PG8_STAGE(PG8_SA(0, 0), a2, voffA);
            PG8_BAR; PG8_WAIT_L(0); PG8_MMA(1, 0, At, B0); PG8_BAR; PG8_SCHED;
            PG8_STAGE(PG8_SB(0, 1), b2 + hstepB, voffB);
            PG8_WAIT_V(6); PG8_BAR; PG8_MMA(1, 1, At, B1); PG8_BAR;
            PG8_LDB(B0, 1, 0); PG8_SCHED; PG8_LDA(At, 1, 0); PG8_STAGE(PG8_SA(0, 1), a2 + hstepA, voffA);
            PG8_WAIT_L(8); PG8_BAR; PG8_WAIT_L(0); PG8_MMA(0, 0, At, B0); PG8_BAR; PG8_SCHED;
            PG8_LDB(B1, 1, 1); PG8_STAGE(PG8_SB(1, 0), b3, voffB);
            PG8_BAR; PG8_WAIT_L(0); PG8_MMA(0, 1, At, B1); PG8_BAR;
            PG8_LDA(At, 1, 1); PG8_STAGE(PG8_SA(1, 0), a3, voffA);
            PG8_BAR; PG8_WAIT_L(0); PG8_MMA(1, 0, At, B0); PG8_BAR; PG8_SCHED;
            PG8_STAGE(PG8_SB(1, 1), b3 + hstepB, voffB);
            PG8_WAIT_V(6); PG8_BAR; PG8_MMA(1, 1, At, B1); PG8_BAR;
        }
        if constexpr (!Epi::AFTER_DRAIN) E(acc, cur, wr, wc, fr, fq);
        if (!has_next) break;
#pragma unroll
        for (int a = 0; a < 2; ++a)
#pragma unroll
            for (int b = 0; b < 2; ++b)
#pragma unroll
                for (int m = 0; m < 4; ++m)
#pragma unroll
                    for (int n = 0; n < 2; ++n) acc[a][b][m][n] = (f32x4){0.f, 0.f, 0.f, 0.f};
        cur = nxt; cA = nA; cB = nB; ++ui;
    }
    PG8_WAIT_V(0);
    if (wr == 0) PG8_BAR;
    PG8_BAR;
    if constexpr (Epi::AFTER_DRAIN) E.fused(acc, cur, wr, wc, fr, fq, tid);
#undef PG8_SA
#undef PG8_SB
#undef PG8_STAGE
#undef PG8_LDA
#undef PG8_LDB
#undef PG8_MMA
#undef PG8_WAIT_V
#undef PG8_WAIT_L
#undef PG8_BAR
#undef PG8_SCHED
}
}

__device__ __forceinline__ void transpose_item(const float* W, bf16_t* WT, const float* gain, int K, int ldw, int col0, int nvalid, int nblk, int mode, int item, int lane) {
    const int kb = item / nblk, nb = item - kb * nblk, k0 = 64 * kb, n0 = 64 * nb;
    const bool ok = (n0 + lane) < nvalid;
    const float* rowbase = W + (size_t)k0 * ldw + col0 + n0;
    const unsigned loff = ok ? (unsigned)lane : 0u;
    float v[64];
#pragma unroll
    for (int i = 0; i < 64; ++i) v[i] = __builtin_nontemporal_load(rowbase + (size_t)i * ldw + loff);
    if (gain) {
#pragma unroll
        for (int i = 0; i < 64; ++i) v[i] *= gain[k0 + i];
    }
    const int drow = ((mode == 0) ? n0 : (256 * (n0 >> 7) + (n0 & 127) + (mode == 2 ? 128 : 0))) + lane;
    u32x4* dst = (u32x4*)(WT + (size_t)drow * K + k0);
#pragma unroll
    for (int c = 0; c < 8; ++c) {
        u32x4 o; o.x = cvt_pk_bf16(v[8 * c + 0], v[8 * c + 1]); o.y = cvt_pk_bf16(v[8 * c + 2], v[8 * c + 3]); o.z = cvt_pk_bf16(v[8 * c + 4], v[8 * c + 5]); o.w = cvt_pk_bf16(v[8 * c + 6], v[8 * c + 7]);
        if (!ok) o = (u32x4){0u, 0u, 0u, 0u};
        dst[c] = o;
    }
}

__device__ __forceinline__ void convert_range(const Params& p, int lo, int hi, int widx, int nw, int lane) {
    int d = 0;
    for (int it = lo + widx; it < hi; it += nw) {
        while (it >= p.tstart[d + 1]) ++d;
        const float* W = p.td[d].W; bf16_t* WT = p.td[d].WT; const float* gain = p.td[d].gain; const int K = p.td[d].K, ldw = p.td[d].ldw, col0 = p.td[d].col0, nvalid = p.td[d].nvalid, nblk = p.td[d].nblk, mode = p.td[d].mode;
        transpose_item(W, WT, gain, K, ldw, col0, nvalid, nblk, mode, it - p.tstart[d], lane);
    }
}
__device__ __forceinline__ void prologue_phase(const Params& p, LAS unsigned char* lds, int tid, int wave, int lane) {
    const int gw = blockIdx.x * 8 + wave, NGW = gridDim.x * 8;
    {
        const int n1 = p.tstart[2], base2 = p.tstart[12], total = n1 + (p.tstart[16] - base2);
        int d = 0;
        for (int v = gw; v < total; v += NGW) {
            const int it = (v < n1) ? v : (v - n1 + base2);
            while (it >= p.tstart[d + 1]) ++d;
            const float* W = p.td[d].W; bf16_t* WT = p.td[d].WT; const float* gain = p.td[d].gain; const int K = p.td[d].K, ldw = p.td[d].ldw, col0 = p.td[d].col0, nvalid = p.td[d].nvalid, nblk = p.td[d].nblk, mode = p.td[d].mode;
            transpose_item(W, WT, gain, K, ldw, col0, nvalid, nblk, mode, it - p.tstart[d], lane);
        }
    }
    {
        ss_t* SS = (ss_t*)(p.ws + WS_SS); bf16_t* XB = (bf16_t*)(p.ws + WS_HN); const float* xin = p.in[0];
        for (int m = gw; m < M; m += NGW) {
            const f32x4* xr = (const f32x4*)(xin + (size_t)m * D) + lane; u32x2* o = (u32x2*)(XB + (size_t)m * D) + lane; float sq = 0.f;
#pragma unroll
            for (int j = 0; j < 8; ++j) { const f32x4 v = xr[64 * j]; sq += (v.x * v.x + v.y * v.y) + (v.z * v.z + v.w * v.w); u32x2 w; w.x = cvt_pk_bf16(v.x, v.y); w.y = cvt_pk_bf16(v.z, v.w); o[64 * j] = w; }
            sq = wave_sum(sq);
            if (lane == 0) SS[m] = (ss_t)(sq * SS_SCALE);
        }
        for (int idx = blockIdx.x * 512 + tid; idx < 6 * M; idx += gridDim.x * 512) SS[M + idx] = 0ull;
        if (blockIdx.x == 0 && tid < 32) ((unsigned*)(p.ws + WS_CNT))[64 * tid] = 0u;
        if (blockIdx.x == 1) { u32x4* pad = (u32x4*)(p.ws + WS_KCVC + (size_t)2 * 16 * SEQ * 128 * 2); for (int i = tid; i < 1024; i += 512) pad[i] = (u32x4){0u, 0u, 0u, 0u}; }
    }
    {
        f32x2* rope = (f32x2*)(p.ws + WS_ROPE);
        const int gt = blockIdx.x * 512 + tid, NT = gridDim.x * 512;
        for (int idx = gt; idx < M * 16; idx += NT) {
            const int m = idx >> 4, i = idx & 15;
            const double ang = (double)p.positions[m] * p.inv_freq[i];
            double rev = ang * 0.15915494309189535; rev -= floor(rev);
            const float rf = (float)rev;
            rope[idx] = (f32x2){__builtin_amdgcn_cosf(rf), __builtin_amdgcn_sinf(rf)};
        }
    }
    {
        float* PB = (float*)(p.ws + WS_PB);
        for (int it = gw; it < 512; it += NGW) {
            const int kv = it >> 8, cg4 = (it >> 6) & 3, kc = it & 63;
            const float* pe = p.in[kv ? 30 : 27]; const float* w1 = p.in[kv ? 31 : 28];
            float s = 0.f;
            for (int kk = 0; kk < 64; ++kk) s += pe[64 * kc + kk] * w1[(size_t)(64 * kc + kk) * 256 + 64 * cg4 + lane];
            PB[(kv * 64 + kc) * 256 + 64 * cg4 + lane] = s;
        }
    }
}

__device__ __forceinline__ void norm_phase(const float* X, const float* g, bf16_t* HN, int wave, int lane) {
    const int gw = blockIdx.x * 8 + wave, NGW = gridDim.x * 8;
    for (int m = gw; m < M; m += NGW) {
        const f32x4* xr = (const f32x4*)(X + (size_t)m * D) + lane;
        f32x4 v[8]; float s = 0.f;
#pragma unroll
        for (int j = 0; j < 8; ++j) { v[j] = xr[64 * j]; s += (v[j].x * v[j].x + v[j].y * v[j].y) + (v[j].z * v[j].z + v[j].w * v[j].w); }
        const float rstd = 1.0f / sqrtf(wave_sum(s) * (1.0f / D) + EPS);
        u32x2* o = (u32x2*)(HN + (size_t)m * D) + lane;
#pragma unroll
        for (int j = 0; j < 8; ++j) { const f32x4 gg = ((const f32x4*)g)[lane + 64 * j]; u32x2 w; w.x = cvt_pk_bf16(v[j].x * rstd * gg.x, v[j].y * rstd * gg.y); w.y = cvt_pk_bf16(v[j].z * rstd * gg.z, v[j].w * rstd * gg.w); o[64 * j] = w; }
    }
}
__device__ __forceinline__ void final_norm_phase(const bf16_t* XB, const float* g, float* out, int wave, int lane) {
    const int gw = blockIdx.x * 8 + wave, NGW = gridDim.x * 8;
    for (int m = gw; m < M; m += NGW) {
        const u32x2* xr = (const u32x2*)(XB + (size_t)m * D) + lane;
        f32x4 v[8]; float s = 0.f;
#pragma unroll
        for (int j = 0; j < 8; ++j) { const u32x2 w = xr[64 * j]; v[j] = (f32x4){bflo(w.x), bfhi(w.x), bflo(w.y), bfhi(w.y)}; s += (v[j].x * v[j].x + v[j].y * v[j].y) + (v[j].z * v[j].z + v[j].w * v[j].w); }
        const float rstd = 1.0f / sqrtf(wave_sum(s) * (1.0f / D) + EPS);
        f32x4* o = (f32x4*)(out + (size_t)m * D) + lane;
#pragma unroll
        for (int j = 0; j < 8; ++j) { const f32x4 gg = ((const f32x4*)g)[lane + 64 * j]; o[64 * j] = v[j] * rstd * gg; }
    }
}

__device__ __forceinline__ void conv_gmlp_phase(const Params& p, LAS unsigned char* lds, int tid, int wave, int lane, const int parts = 3) {
    const bf16_t* AG = (const bf16_t*)(p.ws + WS_AG); const bf16_t* UV = (const bf16_t*)(p.ws + WS_UV); bf16_t* MIX = (bf16_t*)(p.ws + WS_MIX);
    const float* conv_w = p.in[8]; const float* conv_b = p.in[9]; const float* cg_ = p.in[10]; const float* cb_ = p.in[11];
    const float* lg = p.in[12]; const float* lb = p.in[13]; const float* gws = p.in[14]; const float* gbs = p.in[15];
    const int gw = blockIdx.x * 8 + wave, NGW = gridDim.x * 8;
    if (parts & 1)
    for (int grp = gw; grp < M / 4; grp += NGW) {
        const int m0 = grp * 4, t0 = m0 & (SEQ - 1);
        const int c0 = 8 * lane, c1 = 512 + 8 * lane;
        float a[4][16];
        { const f32x4 b0 = *(const f32x4*)(conv_b + c0), b1 = *(const f32x4*)(conv_b + c0 + 4), b2 = *(const f32x4*)(conv_b + c1), b3 = *(const f32x4*)(conv_b + c1 + 4);
#pragma unroll
          for (int t = 0; t < 4; ++t)
#pragma unroll
            for (int i = 0; i < 4; ++i) { a[t][i] = b0[i]; a[t][4 + i] = b1[i]; a[t][8 + i] = b2[i]; a[t][12 + i] = b3[i]; } }
        float wr[4][16];
#pragma unroll 1
        for (int r4 = 0; r4 < 36; r4 += 4)
#pragma unroll
        for (int ri = 0; ri < 4; ++ri) {
            const int r = r4 + ri;
            if (r >= 34) continue;
            if (r <= 30) {
                const float* cw = conv_w + r * 1024;
                const f32x4 k0 = *(const f32x4*)(cw + c0), k1 = *(const f32x4*)(cw + c0 + 4), k2 = *(const f32x4*)(cw + c1), k3 = *(const f32x4*)(cw + c1 + 4);
#pragma unroll
                for (int i = 0; i < 4; ++i) { wr[ri][i] = k0[i]; wr[ri][4 + i] = k1[i]; wr[ri][8 + i] = k2[i]; wr[ri][12 + i] = k3[i]; }
            }
            if (t0 - 30 + r >= 0) {
                const bf16_t* row = AG + (size_t)(m0 - 30 + r) * 1024;
                const u32x4 x0 = *(const u32x4*)(row + c0), x1 = *(const u32x4*)(row + c1);
                const float x[16] = {bflo(x0.x), bfhi(x0.x), bflo(x0.y), bfhi(x0.y), bflo(x0.z), bfhi(x0.z), bflo(x0.w), bfhi(x0.w),
                                     bflo(x1.x), bfhi(x1.x), bflo(x1.y), bfhi(x1.y), bflo(x1.z), bfhi(x1.z), bflo(x1.w), bfhi(x1.w)};
#pragma unroll
                for (int t = 0; t < 4; ++t) {
                    const int w = r - t;
                    if (w >= 0 && w <= 30) {
#pragma unroll
                        for (int i = 0; i < 16; ++i) a[t][i] += x[i] * wr[(ri - t) & 3][i];
                    }
                }
            }
        }
        const f32x4 g0 = *(const f32x4*)(cg_ + c0), g1 = *(const f32x4*)(cg_ + c0 + 4), g2 = *(const f32x4*)(cg_ + c1), g3 = *(const f32x4*)(cg_ + c1 + 4);
        const f32x4 e0 = *(const f32x4*)(cb_ + c0), e1 = *(const f32x4*)(cb_ + c0 + 4), e2 = *(const f32x4*)(cb_ + c1), e3 = *(const f32x4*)(cb_ + c1 + 4);
#pragma unroll
        for (int t = 0; t < 4; ++t) {
            float sm = 0.f;
#pragma unroll
            for (int i = 0; i < 16; ++i) sm += a[t][i];
            const float mean = wave_sum(sm) * (1.0f / 1024.0f);
            float q = 0.f;
#pragma unroll
            for (int i = 0; i < 16; ++i) { a[t][i] -= mean; q += a[t][i] * a[t][i]; }
            const float rstd = 1.0f / sqrtf(wave_sum(q) * (1.0f / 1024.0f) + EPS);
            float y[16];
#pragma unroll
            for (int i = 0; i < 4; ++i) { y[i] = silu_f(a[t][i] * rstd * g0[i] + e0[i]); y[4 + i] = silu_f(a[t][4 + i] * rstd * g1[i] + e1[i]); y[8 + i] = silu_f(a[t][8 + i] * rstd * g2[i] + e2[i]); y[12 + i] = silu_f(a[t][12 + i] * rstd * g3[i] + e3[i]); }
            u32x4 o0, o1;
            o0.x = cvt_pk_bf16(y[0], y[1]); o0.y = cvt_pk_bf16(y[2], y[3]); o0.z = cvt_pk_bf16(y[4], y[5]); o0.w = cvt_pk_bf16(y[6], y[7]);
            o1.x = cvt_pk_bf16(y[8], y[9]); o1.y = cvt_pk_bf16(y[10], y[11]); o1.z = cvt_pk_bf16(y[12], y[13]); o1.w = cvt_pk_bf16(y[14], y[15]);
            *(u32x4*)(MIX + (size_t)(m0 + t) * 2048 + c0) = o0; *(u32x4*)(MIX + (size_t)(m0 + t) * 2048 + c1) = o1;
        }
    }
    if (parts & 2)
    for (int u = blockIdx.x; u < 512; u += gridDim.x) {
        const int b = u >> 7, chunk = (u >> 3) & 15, g = u & 7;
        const int m0 = b * SEQ + chunk * 128;
        __syncthreads();
        {
            const int s = tid >> 2, q = tid & 3;
            const bf16_t* src = UV + (size_t)(m0 + s) * 2048 + 1024 + g * 128 + 32 * q;
            float x[32];
#pragma unroll
            for (int i = 0; i < 4; ++i) { const u32x4 v = *(const u32x4*)(src + 8 * i);
                x[8 * i + 0] = bflo(v.x); x[8 * i + 1] = bfhi(v.x); x[8 * i + 2] = bflo(v.y); x[8 * i + 3] = bfhi(v.y); x[8 * i + 4] = bflo(v.z); x[8 * i + 5] = bfhi(v.z); x[8 * i + 6] = bflo(v.w); x[8 * i + 7] = bfhi(v.w); }
            float sm = 0.f;
#pragma unroll
            for (int i = 0; i < 32; ++i) sm += x[i];
            sm += __shfl_xor(sm, 1); sm += __shfl_xor(sm, 2);
            const float mean = sm * (1.0f / 128.0f);
            float qq = 0.f;
#pragma unroll
            for (int i = 0; i < 32; ++i) { x[i] -= mean; qq += x[i] * x[i]; }
            qq += __shfl_xor(qq, 1); qq += __shfl_xor(qq, 2);
            const float rstd = 1.0f / sqrtf(qq * (1.0f / 128.0f) + EPS);
            const float* lgp = lg + g * 128 + 32 * q; const float* lbp = lb + g * 128 + 32 * q;
#pragma unroll
            for (int i = 0; i < 32; ++i) {
                const float yv = x[i] * rstd * lgp[i] + lbp[i];
                *(LAS bf16_t*)(lds + (32 * q + i) * 272 + s * 2) = (bf16_t)(cvt_pk_bf16(yv, 0.f) & 0xffffu);
            }
        }
        __syncthreads();
        {
            const int fr = lane & 15, quad = lane >> 4;
            const int trow = 16 * wave + fr;
            f32x4 acc[8];
#pragma unroll
            for (int nd = 0; nd < 8; ++nd) acc[nd] = (f32x4){0.f, 0.f, 0.f, 0.f};
            const int nks = (wave >> 1) + 1;
            for (int ks = 0; ks < nks; ++ks) {
                const int s0 = 32 * ks + quad * 8;
                const float* wp = gws + ((size_t)g * 128 + trow) * 128 + s0;
                const f32x4 w0 = *(const f32x4*)wp, w1 = *(const f32x4*)(wp + 4);
                float wv[8] = {w0.x, w0.y, w0.z, w0.w, w1.x, w1.y, w1.z, w1.w};
#pragma unroll
                for (int j = 0; j < 8; ++j) wv[j] = (s0 + j <= trow) ? wv[j] : 0.f;
                u32x4 aw; aw.x = cvt_pk_bf16(wv[0], wv[1]); aw.y = cvt_pk_bf16(wv[2], wv[3]); aw.z = cvt_pk_bf16(wv[4], wv[5]); aw.w = cvt_pk_bf16(wv[6], wv[7]);
                const bf16x8 Af = __builtin_bit_cast(bf16x8, aw);
#pragma unroll
                for (int nd = 0; nd < 8; ++nd) {
                    const bf16x8 Bf = *(const LAS bf16x8*)(lds + (16 * nd + fr) * 272 + s0 * 2);
                    acc[nd] = __builtin_amdgcn_mfma_f32_16x16x32_bf16(Bf, Af, acc[nd], 0, 0, 0);
                }
            }
            {
                const int tt = 16 * wave + fr;
                const float bsv = gbs[g * 128 + tt];
                const size_t rowoff = (size_t)(m0 + tt) * 2048;
#pragma unroll
                for (int nd = 0; nd < 8; ++nd) {
                    const int d0 = 16 * nd + 4 * quad;
                    const u32x2 uw = *(const u32x2*)(UV + rowoff + g * 128 + d0);
                    u32x2 ow; ow.x = cvt_pk_bf16(bflo(uw.x) * (acc[nd][0] + bsv), bfhi(uw.x) * (acc[nd][1] + bsv)); ow.y = cvt_pk_bf16(bflo(uw.y) * (acc[nd][2] + bsv), bfhi(uw.y) * (acc[nd][3] + bsv));
                    *(u32x2*)(MIX + rowoff + 1024 + g * 128 + d0) = ow;
                }
            }
        }
    }
}

__device__ __forceinline__ u32x4 scale_chunk(const u32x4 x, float sc) {
    u32x4 w; w.x = cvt_pk_bf16(bflo(x.x) * sc, bfhi(x.x) * sc); w.y = cvt_pk_bf16(bflo(x.y) * sc, bfhi(x.y) * sc); w.z = cvt_pk_bf16(bflo(x.z) * sc, bfhi(x.z) * sc); w.w = cvt_pk_bf16(bflo(x.w) * sc, bfhi(x.w) * sc);
    return w;
}
__device__ __forceinline__ u32x4 rope_chunk(const u32x4 x1, const u32x4 x2, const f32x2* rp, bool first, float sc = 1.0f) {
    float a[8] = {bflo(x1.x), bfhi(x1.x), bflo(x1.y), bfhi(x1.y), bflo(x1.z), bfhi(x1.z), bflo(x1.w), bfhi(x1.w)};
    float b[8] = {bflo(x2.x), bfhi(x2.x), bflo(x2.y), bfhi(x2.y), bflo(x2.z), bfhi(x2.z), bflo(x2.w), bfhi(x2.w)};
    float o[8];
#pragma unroll
    for (int e = 0; e < 8; ++e) { const f32x2 cs = rp[e]; o[e] = (first ? (a[e] * cs.x - b[e] * cs.y) : (b[e] * cs.x + a[e] * cs.y)) * sc; }
    u32x4 w; w.x = cvt_pk_bf16(o[0], o[1]); w.y = cvt_pk_bf16(o[2], o[3]); w.z = cvt_pk_bf16(o[4], o[5]); w.w = cvt_pk_bf16(o[6], o[7]);
    return w;
}
__device__ __forceinline__ void post_phase(const Params& p, LAS unsigned char* lds, int tid) {
    const bf16_t* Z = (const bf16_t*)(p.ws + WS_Z);
    const f32x2* rope = (const f32x2*)(p.ws + WS_ROPE);
    bf16_t* QR = (bf16_t*)(p.ws + WS_QR); bf16_t* KSR = (bf16_t*)(p.ws + WS_KSR); bf16_t* KWR = (bf16_t*)(p.ws + WS_KWR);
    bf16_t* KC = (bf16_t*)(p.ws + WS_KCVC); bf16_t* VC = KC + (size_t)16 * SEQ * 128;
    bf16_t* VST = (bf16_t*)(p.ws + WS_VST); bf16_t* VWT = (bf16_t*)(p.ws + WS_VWT);
    float* GATE = (float*)(p.ws + WS_GATE);
    for (int item = blockIdx.x; item < 256; item += gridDim.x) {
        const int m0 = item * 32, b = m0 >> 11, t0 = m0 & (SEQ - 1);
        for (int idx = tid; idx < 32 * 256; idx += 512) {
            const int row = idx >> 8, ch = idx & 255, hc = ch & 15, m = m0 + row;
            const bf16_t* zr = Z + (size_t)m * ZW;
            u32x4 o;
            if (hc < 4) {
                const int base = (ch & ~15) * 8, i0 = 8 * (hc & 1);
                const u32x4 x1 = *(const u32x4*)(zr + base + i0), x2 = *(const u32x4*)(zr + base + 16 + i0);
                o = rope_chunk(x1, x2, rope + (size_t)m * 16 + i0, hc < 2, SC_LOG2);
            } else o = scale_chunk(*(const u32x4*)(zr + ch * 8), SC_LOG2);
            *(u32x4*)(QR + (size_t)m * 2048 + ch * 8) = o;
        }
        for (int idx = tid; idx < 2 * 32 * 64; idx += 512) {
            const int which = idx >> 11, row = (idx >> 6) & 31, ch = idx & 63, g = ch >> 4, hc = ch & 15, m = m0 + row;
            const int zc = (which == 0) ? 3072 : (which == 1) ? 4096 : (which == 2) ? 2048 : 2560;
            bf16_t* dst = (which == 0) ? KSR : (which == 1) ? KWR : (which == 2) ? KC : VC;
            const bf16_t* zr = Z + (size_t)m * ZW + zc + g * 128;
            u32x4 o;
            if (which < 2 && hc < 4) {
                const int i0 = 8 * (hc & 1);
                const u32x4 x1 = *(const u32x4*)(zr + i0), x2 = *(const u32x4*)(zr + 16 + i0);
                o = rope_chunk(x1, x2, rope + (size_t)m * 16 + i0, hc < 2);
            } else o = *(const u32x4*)(zr + hc * 8);
            *(u32x4*)(dst + ((size_t)(b * 4 + g) * SEQ + t0 + row) * 128 + hc * 8) = o;
        }
        __syncthreads();
        for (int idx = tid; idx < 2 * 32 * 64; idx += 512) { const int which = idx >> 11, row = (idx >> 6) & 31, ch = idx & 63;
            *(LAS u32x4*)(lds + which * 33280 + row * 1040 + ch * 16) = *(const u32x4*)(Z + (size_t)(m0 + row) * ZW + (which ? 4608 : 3584) + ch * 8); }
        __syncthreads();
#pragma unroll
        for (int which = 0; which < 2; ++which) {
            bf16_t* dst = which ? VWT : VST;
            const int g = tid >> 7, d = tid & 127;
            unsigned w[16];
#pragma unroll
            for (int i = 0; i < 16; ++i) { const unsigned lo = *(const LAS bf16_t*)(lds + which * 33280 + (2 * i) * 1040 + tid * 2), hi = *(const LAS bf16_t*)(lds + which * 33280 + (2 * i + 1) * 1040 + tid * 2); w[i] = lo | (hi << 16); }
            u32x4* o = (u32x4*)(dst + ((size_t)(b * 4 + g) * 128 + d) * SEQ + t0);
            o[0] = (u32x4){w[0], w[1], w[2], w[3]}; o[1] = (u32x4){w[4], w[5], w[6], w[7]}; o[2] = (u32x4){w[8], w[9], w[10], w[11]}; o[3] = (u32x4){w[12], w[13], w[14], w[15]};
        }
        for (int idx = tid; idx < 32 * 48; idx += 512) { const int row = idx / 48, c = idx - row * 48, m = m0 + row;
            GATE[(size_t)m * 48 + c] = sigmoid_f(bf1(Z[(size_t)m * ZW + 5120 + c])); }
    }
    if (blockIdx.x == 0) {
        const float* PB = (const float*)(p.ws + WS_PB); float* CB = (float*)(p.ws + WS_CBIAS);
        const int kv = tid >> 8, c = tid & 255; float s = 0.f;
        for (int kc = 0; kc < 64; ++kc) s += PB[(kv * 64 + kc) * 256 + c];
        CB[tid] = s;
    }
}

__device__ __forceinline__ void cmp2_phase(const Params& p, LAS unsigned char* lds, int tid) {
    const float* P = (const float*)(p.ws + WS_H1P); const float* CB = (const float*)(p.ws + WS_CBIAS);
    bf16_t* KCMP = (bf16_t*)(p.ws + WS_KCMP); bf16_t* VCMPT = (bf16_t*)(p.ws + WS_VCMPT);
    LAS float* H = (LAS float*)lds;
    for (int rb = blockIdx.x; rb < 256; rb += gridDim.x) {
        const int r0 = rb * 16;
        __syncthreads();
        {
            const int row = tid >> 5, c8 = (tid & 31) * 8, r = r0 + row;
            f32x4 s0 = *(const f32x4*)(CB + (r >> 11) * 256 + c8), s1 = *(const f32x4*)(CB + (r >> 11) * 256 + c8 + 4);
#pragma unroll
            for (int k = 0; k < 8; ++k) { const float* pp = P + ((size_t)k * 4096 + r) * 256 + c8; s0 = s0 + *(const f32x4*)pp; s1 = s1 + *(const f32x4*)(pp + 4); }
            LAS float* hp = H + row * 256 + c8;
            *(LAS f32x4*)hp = (f32x4){gelu_f(s0[0]), gelu_f(s0[1]), gelu_f(s0[2]), gelu_f(s0[3])};
            *(LAS f32x4*)(hp + 4) = (f32x4){gelu_f(s1[0]), gelu_f(s1[1]), gelu_f(s1[2]), gelu_f(s1[3])};
        }
        __syncthreads();
        {
            const int d = tid & 127, rq = tid >> 7;
            const float* w2 = p.in[(r0 < 2048) ? 29 : 32];
            const LAS float* hp = H + (rq * 4) * 256;
            float a0 = 0.f, a1 = 0.f, a2 = 0.f, a3 = 0.f;
#pragma unroll 8
            for (int c = 0; c < 256; ++c) { const float w = w2[c * 128 + d]; a0 += hp[c] * w; a1 += hp[256 + c] * w; a2 += hp[512 + c] * w; a3 += hp[768 + c] * w; }
            const float av[4] = {a0, a1, a2, a3};
#pragma unroll
            for (int i = 0; i < 4; ++i) {
                const int r = r0 + rq * 4 + i; const bf16_t o = (bf16_t)(cvt_pk_bf16(av[i], 0.f) & 0xffffu);
                if (r < 2048) KCMP[(size_t)r * 128 + d] = o;
                else { const int rr = r - 2048, bg = rr >> 7, n = rr & 127; VCMPT[((size_t)bg * 128 + d) * 128 + n] = o; }
            }
        }
    }
}

constexpr int A_KS = 0, A_VS = 34816, A_IMP = 69632, A_FIMP = 102400, A_MASK = 110592;

struct KVPre { u32x4 k0, k1, v0, v1; };
__device__ __forceinline__ void kv_issue(KVPre& r, const bf16_t* Kg, const bf16_t* VTg, int tid) {
    const int row = tid >> 4, ch = tid & 15, vrow = tid >> 3, vch = tid & 7;
    r.k0 = *(const u32x4*)(Kg + (size_t)row * 128 + ch * 8); r.k1 = *(const u32x4*)(Kg + (size_t)(row + 32) * 128 + ch * 8);
    r.v0 = *(const u32x4*)(VTg + (size_t)vrow * SEQ + vch * 8); r.v1 = *(const u32x4*)(VTg + (size_t)(vrow + 64) * SEQ + vch * 8);
}
template <int MODE>
__device__ __forceinline__ void attn_block(LAS unsigned char* lds, KVPre& pre, const bf16_t* nK, const bf16_t* nVT, int j, const bool full,
                                           const bf16x8 (&Qf)[2][4], f32x4 (&O)[2][8], float (&mrun)[2], float (&lrun)[2],
                                           const int (&tq)[2], const unsigned (&selw)[2], int tid, int fr, int quad) {
    __syncthreads();
    {
        const int row = tid >> 4, ch = tid & 15, vrow = tid >> 3, vch = tid & 7;
        LAS unsigned char* kd = lds + A_KS + row * 272 + ch * 16; LAS unsigned char* vd = lds + A_VS + vrow * 144 + vch * 16;
        *(LAS u32x4*)kd = pre.k0; *(LAS u32x4*)(kd + 32 * 272) = pre.k1; *(LAS u32x4*)vd = pre.v0; *(LAS u32x4*)(vd + 64 * 144) = pre.v1;
    }
    __syncthreads();
    if (nK) kv_issue(pre, nK, nVT, tid);
    const LAS unsigned char* kbase = lds + A_KS + fr * 272 + quad * 16;
    const LAS unsigned char* vbase = lds + A_VS + fr * 144 + quad * 8;
    f32x4 S[2][4];
#pragma unroll
    for (int qt = 0; qt < 2; ++qt)
#pragma unroll
        for (int kt = 0; kt < 4; ++kt) S[qt][kt] = (f32x4){0.f, 0.f, 0.f, 0.f};
#pragma unroll
    for (int kt = 0; kt < 4; ++kt)
#pragma unroll
        for (int kk = 0; kk < 4; ++kk) {
            const bf16x8 Kf = *(const LAS bf16x8*)(kbase + kt * 4352 + kk * 64);
#pragma unroll
            for (int qt = 0; qt < 2; ++qt) S[qt][kt] = __builtin_amdgcn_mfma_f32_16x16x32_bf16(Kf, Qf[qt][kk], S[qt][kt], 0, 0, 0);
        }
    bf16x8 Pf[2][2];
#pragma unroll
    for (int qt = 0; qt < 2; ++qt) {
        const int d0 = tq[qt] - 64 * j - 4 * quad;
        const float selpen = (MODE == 0) ? ((((selw[qt] >> j) & 1u) != 0u) ? 0.f : -1e30f) : 0.f;
        float mx = -3e38f;
        if (full) {
#pragma unroll
            for (int kt = 0; kt < 4; ++kt)
#pragma unroll
                for (int r = 0; r < 4; ++r) { const float s = S[qt][kt][r] + selpen; S[qt][kt][r] = s; mx = fmaxf(mx, s); }
        } else {
#pragma unroll
            for (int kt = 0; kt < 4; ++kt)
#pragma unroll
                for (int r = 0; r < 4; ++r) {
                    const int dv = d0 - (16 * kt + r);
                    int dm = dv < 0 ? dv : 0;
                    if (MODE == 1) { const int d2 = 511 - dv; dm = d2 < dm ? d2 : dm; }
                    const float s = S[qt][kt][r] + ((float)dm * 1e30f + selpen);
                    S[qt][kt][r] = s; mx = fmaxf(mx, s);
                }
        }
        mx = fmaxf(mx, __shfl_xor(mx, 16)); mx = fmaxf(mx, __shfl_xor(mx, 32));
        if (__any(mx > mrun[qt] + 8.0f)) {
            const float mnew = fmaxf(mrun[qt], mx);
            const float alpha = __builtin_amdgcn_exp2f(mrun[qt] - mnew);
            lrun[qt] *= alpha; mrun[qt] = mnew;
#pragma unroll
            for (int dd = 0; dd < 8; ++dd) O[qt][dd] = O[qt][dd] * alpha;
        }
        const float msub = (mrun[qt] > -1e29f) ? mrun[qt] : 1e30f;
        float rs = 0.f;
#pragma unroll
        for (int kt = 0; kt < 4; ++kt)
#pragma unroll
            for (int r = 0; r < 4; ++r) { const float pv = __builtin_amdgcn_exp2f(S[qt][kt][r] - msub); S[qt][kt][r] = pv; rs += pv; }
        lrun[qt] += rs;
#pragma unroll
        for (int ks = 0; ks < 2; ++ks) {
            u32x4 pp; pp.x = cvt_pk_bf16(S[qt][2 * ks][0], S[qt][2 * ks][1]); pp.y = cvt_pk_bf16(S[qt][2 * ks][2], S[qt][2 * ks][3]);
            pp.z = cvt_pk_bf16(S[qt][2 * ks + 1][0], S[qt][2 * ks + 1][1]); pp.w = cvt_pk_bf16(S[qt][2 * ks + 1][2], S[qt][2 * ks + 1][3]);
            Pf[qt][ks] = __builtin_bit_cast(bf16x8, pp);
        }
    }
#pragma unroll
    for (int ks = 0; ks < 2; ++ks)
#pragma unroll
        for (int dd = 0; dd < 8; ++dd) {
            const LAS unsigned char* vp = vbase + dd * 2304 + ks * 64;
            const u32x2 va = *(const LAS u32x2*)vp, vb = *(const LAS u32x2*)(vp + 32);
            const bf16x8 Vf = __builtin_bit_cast(bf16x8, ((u32x4){va.x, va.y, vb.x, vb.y}));
#pragma unroll
            for (int qt = 0; qt < 2; ++qt) O[qt][dd] = __builtin_amdgcn_mfma_f32_16x16x32_bf16(Vf, Pf[qt][ks], O[qt][dd], 0, 0, 0);
        }
}

__device__ __forceinline__ void attn_tile(const Params& p, LAS unsigned char* lds, int bg, int c, int tid_in) {
    int tid = tid_in; asm volatile("" : "+v"(tid));
    const int lane = tid & 63, wave = __builtin_amdgcn_readfirstlane(tid >> 6);
    const bf16_t* Z = (const bf16_t*)(p.ws + WS_Z); const bf16_t* QR = (const bf16_t*)(p.ws + WS_QR);
    const bf16_t* KSR = (const bf16_t*)(p.ws + WS_KSR); const bf16_t* KWR = (const bf16_t*)(p.ws + WS_KWR);
    const bf16_t* VST = (const bf16_t*)(p.ws + WS_VST); const bf16_t* VWT = (const bf16_t*)(p.ws + WS_VWT);
    const bf16_t* KCMP = (const bf16_t*)(p.ws + WS_KCMP); const bf16_t* VCMPT = (const bf16_t*)(p.ws + WS_VCMPT);
    const float* GATE = (const float*)(p.ws + WS_GATE);
    float* OACC = (float*)(p.ws + WS_OACC); bf16_t* OB = (bf16_t*)(p.ws + WS_OB);
    const int b = bg >> 2, g = bg & 3, t0 = c * 64, m0 = b * SEQ + t0;
    const int h = wave & 3, th = wave >> 2, fr = lane & 15, quad = lane >> 4, head = g * 4 + h;
    int tq[2], mrow[2], tl[2];
#pragma unroll
    for (int qt = 0; qt < 2; ++qt) { tl[qt] = 32 * th + 16 * qt + fr; tq[qt] = t0 + tl[qt]; mrow[qt] = m0 + tl[qt]; }
    LAS float* IMP = (LAS float*)(lds + A_IMP); LAS float* FIMP = (LAS float*)(lds + A_FIMP); LAS unsigned* MASK = (LAS unsigned*)(lds + A_MASK);
    bf16x8 Qf[2][4];
    f32x4 O[2][8];

    __syncthreads();
    {
        const bf16_t* kc = KCMP + (size_t)bg * 128 * 128; const bf16_t* vc = VCMPT + (size_t)bg * 128 * 128;
        const int row = tid >> 4, ch = tid & 15;
        LAS unsigned char* kd = lds + A_KS + row * 272 + ch * 16; LAS unsigned char* vd = lds + A_VS + row * 272 + ch * 16;
#pragma unroll
        for (int i = 0; i < 4; ++i) {
            *(LAS u32x4*)(kd + i * 32 * 272) = *(const u32x4*)(kc + (size_t)(row + 32 * i) * 128 + ch * 8);
            *(LAS u32x4*)(vd + i * 32 * 272) = *(const u32x4*)(vc + (size_t)(row + 32 * i) * 128 + ch * 8); }
        if (tid < 64) MASK[tid] = 0u;
    }
#pragma unroll
    for (int qt = 0; qt < 2; ++qt)
#pragma unroll
        for (int kk = 0; kk < 4; ++kk) Qf[qt][kk] = *(const bf16x8*)(Z + (size_t)mrow[qt] * ZW + head * 128 + kk * 32 + quad * 8);
    __syncthreads();
    {
        const int nkt = (c >> 2) + 1;
        const LAS unsigned char* kbase = lds + A_KS + fr * 272 + quad * 16;
        const LAS unsigned char* vbase = lds + A_VS + fr * 272 + quad * 8;
        f32x4 S[2][8];
#pragma unroll
        for (int qt = 0; qt < 2; ++qt)
#pragma unroll
            for (int kt = 0; kt < 8; ++kt) S[qt][kt] = (f32x4){0.f, 0.f, 0.f, 0.f};
#pragma unroll
        for (int kt = 0; kt < 8; ++kt) if (kt < nkt) {
#pragma unroll
            for (int kk = 0; kk < 4; ++kk) {
                const bf16x8 Kf = *(const LAS bf16x8*)(kbase + kt * 4352 + kk * 64);
#pragma unroll
                for (int qt = 0; qt < 2; ++qt) S[qt][kt] = __builtin_amdgcn_mfma_f32_16x16x32_bf16(Kf, Qf[qt][kk], S[qt][kt], 0, 0, 0);
            }
        }
#pragma unroll
        for (int qt = 0; qt < 2; ++qt) {
            const int d0 = tq[qt] - 31 - 64 * quad;
            float mx = -3e38f;
#pragma unroll
            for (int kt = 0; kt < 8; ++kt) if (kt < nkt)
#pragma unroll
                for (int r = 0; r < 4; ++r) { const int dv = d0 - (256 * kt + 16 * r); const int dm = dv < 0 ? dv : 0;
                    const float s = S[qt][kt][r] * SC_LOG2 + (float)dm * 1e30f; S[qt][kt][r] = s; mx = fmaxf(mx, s); }
            mx = fmaxf(mx, __shfl_xor(mx, 16)); mx = fmaxf(mx, __shfl_xor(mx, 32));
            const float msub = (mx > -1e29f) ? mx : 1e30f;
            float rs = 0.f;
#pragma unroll
            for (int kt = 0; kt < 8; ++kt) if (kt < nkt)
#pragma unroll
                for (int r = 0; r < 4; ++r) { const float pv = __builtin_amdgcn_exp2f(S[qt][kt][r] - msub); S[qt][kt][r] = pv; rs += pv; }
            rs += __shfl_xor(rs, 16); rs += __shfl_xor(rs, 32);
            const float inv = rs > 0.f ? 1.0f / rs : 0.f;
#pragma unroll
            for (int kt = 0; kt < 8; ++kt) if (kt < nkt) S[qt][kt] = S[qt][kt] * inv;
            const int src = (lane + 48) & 63;
            float prev3 = 0.f;
            LAS float* ip = IMP + (h * 64 + tl[qt]) * 32 + quad;
#pragma unroll
            for (int kt = 0; kt < 8; ++kt) {
                const float gsum = (S[qt][kt][0] + S[qt][kt][1]) + (S[qt][kt][2] + S[qt][kt][3]);
                const float a = __shfl(S[qt][kt][3], src);
                const float e = (quad > 0) ? a : prev3;
                prev3 = a;
                ip[4 * kt] = gsum + e;
            }
        }
#pragma unroll
        for (int qt = 0; qt < 2; ++qt)
#pragma unroll
            for (int dd = 0; dd < 8; ++dd) O[qt][dd] = (f32x4){0.f, 0.f, 0.f, 0.f};
#pragma unroll
        for (int ks = 0; ks < 4; ++ks) if (2 * ks < nkt) {
            bf16x8 Pf[2];
#pragma unroll
            for (int qt = 0; qt < 2; ++qt) {
                u32x4 pp; pp.x = cvt_pk_bf16(S[qt][2 * ks][0], S[qt][2 * ks][1]); pp.y = cvt_pk_bf16(S[qt][2 * ks][2], S[qt][2 * ks][3]);
                pp.z = cvt_pk_bf16(S[qt][2 * ks + 1][0], S[qt][2 * ks + 1][1]); pp.w = cvt_pk_bf16(S[qt][2 * ks + 1][2], S[qt][2 * ks + 1][3]);
                Pf[qt] = __builtin_bit_cast(bf16x8, pp);
            }
#pragma unroll
            for (int dd = 0; dd < 8; ++dd) {
                const LAS unsigned char* vp = vbase + dd * 4352 + ks * 64;
                const u32x2 va = *(const LAS u32x2*)vp, vb = *(const LAS u32x2*)(vp + 32);
                const bf16x8 Vf = __builtin_bit_cast(bf16x8, ((u32x4){va.x, va.y, vb.x, vb.y}));
#pragma unroll
                for (int qt = 0; qt < 2; ++qt) O[qt][dd] = __builtin_amdgcn_mfma_f32_16x16x32_bf16(Vf, Pf[qt], O[qt][dd], 0, 0, 0);
            }
        }
#pragma unroll
        for (int qt = 0; qt < 2; ++qt) {
            const float gc = GATE[(size_t)mrow[qt] * 48 + head * 3 + 0];
            float* op = OACC + (size_t)mrow[qt] * 2048 + head * 128 + 4 * quad;
#pragma unroll
            for (int dd = 0; dd < 8; ++dd) *(f32x4*)(op + 16 * dd) = O[qt][dd] * gc;
#if DBG_DUMP
            { bf16_t* dp = (bf16_t*)(p.ws + (WS_W + 132 * MiB)) + (size_t)mrow[qt] * 2048 + head * 128 + 4 * quad;
#pragma unroll
              for (int dd = 0; dd < 8; ++dd) { u32x2 w; w.x = cvt_pk_bf16(O[qt][dd][0], O[qt][dd][1]); w.y = cvt_pk_bf16(O[qt][dd][2], O[qt][dd][3]); *(u32x2*)(dp + 16 * dd) = w; } }
#endif
        }
    }
    __syncthreads();
    {
        const int tok = tid >> 3, jg = tid & 7;
#pragma unroll
        for (int e = 0; e < 4; ++e) {
            const int j = 4 * jg + e;
            float v = (IMP[(0 * 64 + tok) * 32 + j] + IMP[(1 * 64 + tok) * 32 + j]) + (IMP[(2 * 64 + tok) * 32 + j] + IMP[(3 * 64 + tok) * 32 + j]);
            if (j == 0 || j == c || j == c - 1) v += 1000.0f;
            FIMP[tok * 32 + j] = (j <= c) ? v : -1e30f;
        }
    }
    __syncthreads();
    {
        const int tok = tid >> 3, jg = tid & 7;
        unsigned bits = 0u;
#pragma unroll 1
        for (int e = 0; e < 4; ++e) {
            const int j = 4 * jg + e; const float vj = FIMP[tok * 32 + j]; int rank = 0;
#pragma unroll 4
            for (int j2 = 0; j2 < 32; ++j2) { const float v2 = FIMP[tok * 32 + j2]; rank += (v2 > vj || (v2 == vj && j2 < j)) ? 1 : 0; }
            if (j <= c && rank < 16) bits |= (1u << j);
        }
        if (bits) __hip_atomic_fetch_or(MASK + tok, bits, __ATOMIC_RELAXED, __HIP_MEMORY_SCOPE_WORKGROUP);
    }
    __syncthreads();
    unsigned selw[2]; unsigned U;
    {
        selw[0] = MASK[tl[0]]; selw[1] = MASK[tl[1]];
        unsigned mw = MASK[lane];
#pragma unroll
        for (int o = 1; o < 64; o <<= 1) mw |= (unsigned)__shfl_xor((int)mw, o);
        U = (unsigned)__builtin_amdgcn_readfirstlane((int)mw);
    }
#pragma unroll
    for (int qt = 0; qt < 2; ++qt)
#pragma unroll
        for (int kk = 0; kk < 4; ++kk) Qf[qt][kk] = *(const bf16x8*)(QR + (size_t)mrow[qt] * 2048 + head * 128 + kk * 32 + quad * 8);
    float mrun[2], lrun[2];
#pragma unroll
    for (int qt = 0; qt < 2; ++qt) { mrun[qt] = -1e30f; lrun[qt] = 0.f;
#pragma unroll
        for (int dd = 0; dd < 8; ++dd) O[qt][dd] = (f32x4){0.f, 0.f, 0.f, 0.f}; }
    KVPre pre;
    const int jw0 = (c >= 8) ? c - 8 : 0;
    kv_issue(pre, KSR + (size_t)bg * SEQ * 128, VST + (size_t)bg * 128 * SEQ, tid);
    {
        int j = 0;
#pragma unroll 1
        for (;;) {
            const unsigned rest = (j < 31) ? (U >> (j + 1)) : 0u;
            const int nj = rest ? (j + 1 + __builtin_ctz(rest)) : -1;
            const bf16_t* nK = (nj >= 0) ? KSR + ((size_t)bg * SEQ + 64 * nj) * 128 : KWR + ((size_t)bg * SEQ + 64 * jw0) * 128;
            const bf16_t* nV = (nj >= 0) ? VST + (size_t)bg * 128 * SEQ + 64 * nj : VWT + (size_t)bg * 128 * SEQ + 64 * jw0;
            attn_block<0>(lds, pre, nK, nV, j, j < c, Qf, O, mrun, lrun, tq, selw, tid, fr, quad);
            if (nj < 0) break;
            j = nj;
        }
    }
#pragma unroll
    for (int qt = 0; qt < 2; ++qt) {
        float lt = lrun[qt]; lt += __shfl_xor(lt, 16); lt += __shfl_xor(lt, 32);
        const float gs = GATE[(size_t)mrow[qt] * 48 + head * 3 + 1] * (lt > 0.f ? 1.0f / lt : 0.f);
        float* op = OACC + (size_t)mrow[qt] * 2048 + head * 128 + 4 * quad;
#pragma unroll
        for (int dd = 0; dd < 8; ++dd) { const f32x4 prev = *(const f32x4*)(op + 16 * dd); *(f32x4*)(op + 16 * dd) = prev + O[qt][dd] * gs; }
#if DBG_DUMP
        { const float il = (lrun[qt] > 0.f ? 1.0f / lrun[qt] : 0.f); bf16_t* dp = (bf16_t*)(p.ws + (WS_W + 164 * MiB)) + (size_t)mrow[qt] * 2048 + head * 128 + 4 * quad;
#pragma unroll
          for (int dd = 0; dd < 8; ++dd) { u32x2 w; w.x = cvt_pk_bf16(O[qt][dd][0] * il, O[qt][dd][1] * il); w.y = cvt_pk_bf16(O[qt][dd][2] * il, O[qt][dd][3] * il); *(u32x2*)(dp + 16 * dd) = w; }
          if (h == 0) ((unsigned*)(p.ws + (WS_W + 130 * MiB)))[(size_t)mrow[qt] * 4 + g] = selw[qt]; }
#endif
    }
#pragma unroll
    for (int qt = 0; qt < 2; ++qt) { mrun[qt] = -1e30f; lrun[qt] = 0.f;
#pragma unroll
        for (int dd = 0; dd < 8; ++dd) O[qt][dd] = (f32x4){0.f, 0.f, 0.f, 0.f}; }
#pragma unroll 1
    for (int j = jw0; j <= c; ++j) {
        const bf16_t* nK = (j < c) ? KWR + ((size_t)bg * SEQ + 64 * (j + 1)) * 128 : nullptr;
        const bf16_t* nV = (j < c) ? VWT + (size_t)bg * 128 * SEQ + 64 * (j + 1) : nullptr;
        attn_block<1>(lds, pre, nK, nV, j, (j < c) && (j + 7 >= c), Qf, O, mrun, lrun, tq, selw, tid, fr, quad);
    }
#pragma unroll
    for (int qt = 0; qt < 2; ++qt) {
        float lt = lrun[qt]; lt += __shfl_xor(lt, 16); lt += __shfl_xor(lt, 32);
        const float gwv = GATE[(size_t)mrow[qt] * 48 + head * 3 + 2] * (lt > 0.f ? 1.0f / lt : 0.f);
        const float* op = OACC + (size_t)mrow[qt] * 2048 + head * 128 + 4 * quad;
        bf16_t* ob = OB + (size_t)mrow[qt] * 2048 + head * 128 + 4 * quad;
#pragma unroll
        for (int dd = 0; dd < 8; ++dd) { const f32x4 v = *(const f32x4*)(op + 16 * dd) + O[qt][dd] * gwv;
            u32x2 w; w.x = cvt_pk_bf16(v[0], v[1]); w.y = cvt_pk_bf16(v[2], v[3]); *(u32x2*)(ob + 16 * dd) = w; }
#if DBG_DUMP
        { const float il = (lrun[qt] > 0.f ? 1.0f / lrun[qt] : 0.f); bf16_t* dp = (bf16_t*)(p.ws + (WS_W + 98 * MiB)) + (size_t)mrow[qt] * 2048 + head * 128 + 4 * quad;
#pragma unroll
          for (int dd = 0; dd < 8; ++dd) { u32x2 w; w.x = cvt_pk_bf16(O[qt][dd][0] * il, O[qt][dd][1] * il); w.y = cvt_pk_bf16(O[qt][dd][2] * il, O[qt][dd][3] * il); *(u32x2*)(dp + 16 * dd) = w; } }
#endif
    }
}
__device__ __forceinline__ void attn_phase(const Params& p, LAS unsigned char* lds, int tid, int lane, int wave) {
#pragma unroll 1
    for (int it = blockIdx.x; it < 256; it += gridDim.x) {
        const int bg = it >> 4, cc = it & 15;
#pragma unroll 1
        for (int half = 0; half < 2; ++half) attn_tile(p, lds, bg, half ? cc : 31 - cc, tid);
    }
}


#define XB_TMO      128
#define XB_XCNT(j)  (256  + 64 * (j))
#define XB_XSUB(j)  (1280 + 64 * (j))
#define XB_XGEN(j)  (2304 + 64 * (j))
#define XB_TOP      3328
#define XB_TOPGEN   3392
#define XCD_BAR_WORDS 3456
#define XB_SPIN_CAP (1u << 18)
__device__ __forceinline__ unsigned xb_ld(unsigned* p)              { return __hip_atomic_load(p, __ATOMIC_RELAXED, __HIP_MEMORY_SCOPE_AGENT); }
__device__ __forceinline__ unsigned xb_add(unsigned* p, unsigned v) { return __hip_atomic_fetch_add(p, v, __ATOMIC_RELAXED, __HIP_MEMORY_SCOPE_AGENT); }
__device__ __forceinline__ unsigned xb_xcc_id() { return (unsigned)__builtin_amdgcn_s_getreg((3 << 11) | 20) & 0xFu; }
#define XB_SPIN(cond, bar) do { unsigned _sp = 0; while (cond) { __builtin_amdgcn_s_sleep(1); \
    if ((++_sp & 255u) == 0u) { if (xb_ld(&(bar)[XB_TMO])) break; if (_sp > XB_SPIN_CAP) { atomicAdd(&(bar)[XB_TMO], 1u); break; } } } } while (0)
struct XcdBarrier { unsigned* bar; unsigned x; volatile LAS unsigned* st; };
__device__ __forceinline__ XcdBarrier xcd_barrier_post(unsigned* bar, volatile LAS unsigned* st) {
    XcdBarrier b; b.bar = bar; b.x = xb_xcc_id(); b.st = st;
    if (threadIdx.x == 0) (void)xb_add(&bar[XB_XCNT(b.x)], 1u);
    return b;
}
__device__ __forceinline__ void xcd_barrier_complete(unsigned* bar, unsigned x, unsigned& nloc, unsigned& nx) {
    const unsigned G = gridDim.x * gridDim.y * gridDim.z;
    unsigned sum, cnt, mine, sp = 0u;
    for (;;) {
        sum = 0u; cnt = 0u; mine = 0u;
#pragma unroll
        for (unsigned j = 0; j < 16; ++j) { const unsigned c = xb_ld(&bar[XB_XCNT(j)]); sum += c; cnt += (c > 0u) ? 1u : 0u; mine = (j == x) ? c : mine; }
        if (sum == G) break;
        __builtin_amdgcn_s_sleep(1);
        if ((++sp & 255u) == 0u) { if (xb_ld(&bar[XB_TMO])) break; if (sp > XB_SPIN_CAP) { atomicAdd(&bar[XB_TMO], 1u); break; } }
    }
    nloc = mine > 0u ? mine : 1u; nx = cnt > 0u ? cnt : 1u;
}
__device__ __forceinline__ void xcd_barrier(const XcdBarrier& b) {
    asm volatile("s_waitcnt vmcnt(0)" ::: "memory");
    __syncthreads();
    if (threadIdx.x == 0) {
        unsigned* bar = b.bar;
        __builtin_amdgcn_s_waitcnt(0);
        unsigned nloc = b.st[0], nx = b.st[1];
        if (nloc == 0u) { xcd_barrier_complete(bar, b.x, nloc, nx); b.st[0] = nloc; b.st[1] = nx; }
        const unsigned old = xb_add(&bar[XB_XSUB(b.x)], 1u);
        const unsigned gen = old / nloc;
        if (old + 1u == (gen + 1u) * nloc) {
            __builtin_amdgcn_fence(__ATOMIC_RELEASE, "agent");
            asm volatile("s_waitcnt vmcnt(0)" ::: "memory");
            const unsigned og = xb_add(&bar[XB_TOP], 1u);
            const unsigned tg = og / nx;
            if (og + 1u == (tg + 1u) * nx) xb_add(&bar[XB_TOPGEN], 1u);
            else XB_SPIN(xb_ld(&bar[XB_TOPGEN]) == tg, bar);
            __builtin_amdgcn_fence(__ATOMIC_ACQUIRE, "agent");
            xb_add(&bar[XB_XGEN(b.x)], 1u);
            asm volatile("s_waitcnt vmcnt(0)" ::: "memory");
        } else {
            XB_SPIN(xb_ld(&bar[XB_XGEN(b.x)]) == gen, bar);
            __builtin_amdgcn_fence(__ATOMIC_ACQUIRE, "agent");
            asm volatile("s_waitcnt vmcnt(0)" ::: "memory");
        }
    }
    __syncthreads();
}
constexpr size_t WS_BAR = 3 * MiB + 768 * 1024;
constexpr int MISC_OFF = 131072 + 320;

#define RUN(k) (p.ph_lo <= (k) && (k) < p.ph_hi)
#define SEAM(k) do { if (p.ph_lo <= (k) && (k) + 1 < p.ph_hi) { if (p.ph_lo < -5) grid.sync(); else xcd_barrier(xbar); } } while (0)
#define TIDS int tid = threadIdx.x; asm volatile("" : "+v"(tid)); const int lane = tid & 63, wave = __builtin_amdgcn_readfirstlane(tid >> 6); (void)lane; (void)wave

template <int F, int K0, int SSI>
__device__ __forceinline__ void ffn_block(const Params& p, LAS unsigned char* lds, cg::grid_group& grid, const XcdBarrier& xbar, const float* xin, const float* normw) {
    unsigned char* ws = p.ws;
    float* X = (float*)(ws + WS_X); bf16_t* HN = (bf16_t*)(ws + WS_HN); bf16_t* ACT = (bf16_t*)(ws + WS_ACT);
    ss_t* SS = (ss_t*)(ws + WS_SS);
    if (RUN(K0 + 1)) { TIDS;
        pg8::Gemm g{HN, (const bf16_t*)(ws + WS_WGU(F)), M, 2 * FF, D, D, D};
        pg8::StaticOrder S; S.init(M, 2 * FF, gridDim.x, blockIdx.x);
        pg8::EpiSwiGLU E{ACT, SS + (size_t)SSI * M};
        pg8::gemm_phase(lds, g, S, E, tid);
        {
            const int half = (int)gridDim.x / 2, CAP = 4608;
            const int gwv = (int)blockIdx.x * 8 + wave, ngw = (int)gridDim.x * 8;
            const int widx = ((int)blockIdx.x - half) * 8 + wave, nw = ((int)gridDim.x - half) * 8;
            const bool upper = (int)blockIdx.x >= half;
            if (F < 2) {
                const int lo = p.tstart[3 * F + 2], hi = p.tstart[3 * F + 5], mid = (lo + CAP < hi) ? lo + CAP : hi;
                if (upper) convert_range(p, lo, mid, widx, nw, lane);
                convert_range(p, mid, hi, gwv, ngw, lane);
            }
            if (F == 2) {
                const int lo2 = p.tstart[16], hi2 = p.tstart[20], mid2 = (lo2 + (CAP - 2816) < hi2) ? lo2 + (CAP - 2816) : hi2;
                if (upper) { convert_range(p, p.tstart[8], p.tstart[9], widx, nw, lane); convert_range(p, lo2, mid2, widx, nw, lane); }
                convert_range(p, mid2, hi2, gwv, ngw, lane);
            }
            if (F == 3) { if (upper) convert_range(p, p.tstart[11], p.tstart[12], widx, nw, lane); }
        }
#if PROBE_UP
        pg8::gemm_phase(lds, g, S, E, tid);
#endif
        }
    SEAM(K0 + 1);
    if (RUN(K0 + 2)) { TIDS;
        pg8::Gemm g{ACT, (const bf16_t*)(ws + WS_WD(F)), M, D, FF, FF, FF};
        pg8::StaticOrder S; S.init(M, D, gridDim.x, blockIdx.x);
        if (F == 3 && gridDim.x == 256) {
            pg8::EpiResidFinal E{HN, SS + (size_t)(SSI + 1) * M, (unsigned*)(ws + WS_CNT), p.in[38], p.out};
            pg8::gemm_phase(lds, g, S, E, tid);
        } else {
            pg8::EpiResid<true, F == 0> E{xin, HN, SS + (size_t)(SSI + 1) * M};
            pg8::gemm_phase(lds, g, S, E, tid);
        } }
    if (F < 3 || gridDim.x != 256) SEAM(K0 + 2);
}

__global__ void __launch_bounds__(512, 2) fwd_kernel(Params p) {
    extern __shared__ __attribute__((aligned(16))) unsigned char lds_raw[];
    LAS unsigned char* lds = (LAS unsigned char*)lds_raw;
    cg::grid_group grid = cg::this_grid();
    unsigned char* ws = p.ws;
    float* X = (float*)(ws + WS_X); bf16_t* HN = (bf16_t*)(ws + WS_HN);
    XcdBarrier xbar; xbar.bar = (unsigned*)(ws + WS_BAR); xbar.x = 0; xbar.st = nullptr;
    if (p.ph_hi - p.ph_lo > 1) {
        volatile LAS unsigned* misc = (volatile LAS unsigned*)(lds + MISC_OFF);
        if (threadIdx.x < 32) misc[threadIdx.x] = 0u;
        __syncthreads();
        xbar = xcd_barrier_post((unsigned*)(ws + WS_BAR), misc + 8);
    }

    if (RUN(0)) { TIDS; prologue_phase(p, lds, tid, wave, lane); }
#if PROBE_PRO
    if (RUN(0)) { TIDS; prologue_phase(p, lds, tid, wave, lane); }
#endif
    SEAM(0);
    ffn_block<0, 1, 0>(p, lds, grid, xbar, p.in[0], p.in[2]);
    ss_t* SS = (ss_t*)(ws + WS_SS);
    if (RUN(5)) { TIDS;
        pg8::Gemm g{HN, (const bf16_t*)(ws + WS_WIN0), M, 4096, D, D, D};
        pg8::StaticOrder S; S.init(M, 4096, gridDim.x, blockIdx.x);
        pg8::EpiL0In E{(bf16_t*)(ws + WS_AG), (bf16_t*)(ws + WS_UV), SS + (size_t)1 * M};
        pg8::gemm_phase(lds, g, S, E, tid); }
    SEAM(5);
    if (RUN(6)) { TIDS; conv_gmlp_phase(p, lds, tid, wave, lane); }
#if PROBE_SMALL
    if (RUN(6)) { TIDS; conv_gmlp_phase(p, lds, tid, wave, lane, PROBE_PARTS); }
#endif
    SEAM(6);
    if (RUN(7)) { TIDS;
        pg8::Gemm g{(const bf16_t*)(ws + WS_MIX), (const bf16_t*)(ws + WS_WOUT0), M, D, D, D, D};
        pg8::StaticOrder S; S.init(M, D, gridDim.x, blockIdx.x);
        pg8::EpiResid<false, false> E{nullptr, HN, SS + (size_t)2 * M};
        pg8::gemm_phase(lds, g, S, E, tid); }
    SEAM(7);
    ffn_block<1, 8, 2>(p, lds, grid, xbar, X, p.in[17]);
    ffn_block<2, 11, 3>(p, lds, grid, xbar, X, p.in[21]);
    if (RUN(15)) { TIDS;
        pg8::Gemm g{HN, (const bf16_t*)(ws + WS_WIN1), M, ZW, D, D, D};
        pg8::StaticOrder S; S.init(M, ZW, gridDim.x, blockIdx.x);
        pg8::EpiBf16 E{(bf16_t*)(ws + WS_Z), ZW, SS + (size_t)4 * M, (bf16_t*)(ws + WS_KCVC)};
        pg8::gemm_phase(lds, g, S, E, tid);
        {
            const int lo = ((M / 256) * (ZW / 256)) % (int)gridDim.x;
            const int c0 = p.tstart[9], c1 = p.tstart[11], cm = (c0 + 3456 < c1) ? c0 + 3456 : c1;
            if ((int)blockIdx.x >= lo) convert_range(p, c0, cm, ((int)blockIdx.x - lo) * 8 + wave, ((int)gridDim.x - lo) * 8, lane);
            convert_range(p, cm, c1, (int)blockIdx.x * 8 + wave, (int)gridDim.x * 8, lane);
        } }
    SEAM(15);
    if (RUN(16)) { TIDS; post_phase(p, lds, tid);
        __syncthreads();
        pg8::Gemm g{(const bf16_t*)(ws + WS_KCVC), (const bf16_t*)(ws + WS_W1T), 4096, 256, 512, 2048, 4096};
        pg8::CmpOrder S{(int)gridDim.x, (int)blockIdx.x};
        pg8::EpiCmp E{(float*)(ws + WS_H1P)};
        pg8::gemm_phase(lds, g, S, E, tid); }
    SEAM(17);
    if (RUN(18)) { TIDS; cmp2_phase(p, lds, tid); }
    SEAM(18);
    if (RUN(19)) { TIDS; attn_phase(p, lds, tid, lane, wave); }
#if PROBE_ATT
    if (RUN(19)) { TIDS; attn_phase(p, lds, tid, lane, wave); }
#endif
    SEAM(19);
    if (RUN(20) && DBG_P20) { TIDS;
        pg8::Gemm g{(const bf16_t*)(ws + WS_OB), (const bf16_t*)(ws + WS_WOUT1), M, D, D, D, D};
        pg8::StaticOrder S; S.init(M, D, gridDim.x, blockIdx.x);
        pg8::EpiResid<false, false> E{nullptr, HN, SS + (size_t)5 * M};
        pg8::gemm_phase(lds, g, S, E, tid); }
    SEAM(20);
    ffn_block<3, 21, 5>(p, lds, grid, xbar, X, p.in[34]);
#if PROBE_SYNC
    if (RUN(24)) { for (int i = 0; i < 20; ++i) grid.sync(); }
#endif
    if (RUN(24) && gridDim.x != 256) { TIDS; final_norm_phase(HN, p.in[38], p.out, wave, lane); }
}

#if DEBUG_CHECK
constexpr size_t WS_XOLD = 563 * MiB, WS_FLAG = 3 * MiB + 512 * 1024;
constexpr size_t WS_DOC = WS_W + 132 * MiB, WS_DOS = WS_W + 164 * MiB, WS_DOW = WS_W + 98 * MiB, WS_SELM = WS_W + 130 * MiB;
__device__ __forceinline__ unsigned hsh(unsigned x) { x ^= x >> 16; x *= 0x7feb352du; x ^= x >> 15; x *= 0x846ca68bu; x ^= x >> 16; return x; }
__device__ __forceinline__ float dotA(const bf16_t* a, int K, const float* W, int ldw, int col) { float s = 0.f; for (int k = 0; k < K; ++k) s += bf1(a[k]) * W[(size_t)k * ldw + col]; return s; }
__device__ __forceinline__ void chk_fail(unsigned* flag, unsigned code) { atomicMin(flag, code); }
__device__ __forceinline__ bool bad(float got, float ref, float atol) { const float e = fabsf(got - ref); return !(e <= atol + 0.03f * fabsf(ref)); }
__global__ void __launch_bounds__(64) chk_kernel(Params p, int ph) {
    unsigned char* ws = p.ws; unsigned* flag = (unsigned*)(ws + WS_FLAG);
    const float* X = (const float*)(ws + WS_X); const bf16_t* HN = (const bf16_t*)(ws + WS_HN); const bf16_t* ACT = (const bf16_t*)(ws + WS_ACT);
    const float* XOLD = (const float*)(ws + WS_XOLD);
    const int gt = blockIdx.x * 64 + threadIdx.x;
    const unsigned h1 = hsh(gt * 2654435761u + ph * 97u + 12345u), h2 = hsh(h1 + 0x9e3779b9u), h3 = hsh(h2 + 77u);
    const int m = h1 % M;
    const unsigned code = (unsigned)ph;
    __shared__ float sp[16][4][128]; __shared__ float simp[16][32];
    switch (ph) {
    case 1: case 4: case 8: case 11: case 14: case 21: {
        const float* src = (ph == 1) ? p.in[0] : X; const float* g = p.in[ph == 1 ? 2 : ph == 4 ? 6 : ph == 8 ? 17 : ph == 11 ? 21 : ph == 14 ? 25 : 34];
        const int n = h2 % D; float ss = 0.f; for (int k = 0; k < D; ++k) { const float v = src[(size_t)m * D + k]; ss += v * v; }
        const float ref = src[(size_t)m * D + n] / sqrtf(ss / D + EPS) * g[n];
        if (bad(bf1(HN[(size_t)m * D + n]), ref, 0.02f)) chk_fail(flag, code);
    } break;
    case 2: case 9: case 12: case 22: {
        const int fi = (ph == 2) ? 3 : (ph == 9) ? 18 : (ph == 12) ? 22 : 35; const int n = h2 % FF;
        const float g = dotA(HN + (size_t)m * D, D, p.in[fi], FF, n), u = dotA(HN + (size_t)m * D, D, p.in[fi + 1], FF, n);
        const float ref = g / (1.f + expf(-g)) * u;
        if (bad(bf1(ACT[(size_t)m * FF + n]), ref, 0.03f)) chk_fail(flag, code);
    } break;
    case 3: case 10: case 13: case 23: {
        const int fi = (ph == 3) ? 5 : (ph == 10) ? 20 : (ph == 13) ? 24 : 37; const int n = h2 % D;
        const float* xo = (ph == 3) ? p.in[0] : XOLD;
        const float ref = xo[(size_t)m * D + n] + 0.5f * dotA(ACT + (size_t)m * FF, FF, p.in[fi], D, n);
        if (bad(X[(size_t)m * D + n], ref, 0.03f)) chk_fail(flag, code);
    } break;
    case 5: {
        const bf16_t* AG = (const bf16_t*)(ws + WS_AG); const bf16_t* UV = (const bf16_t*)(ws + WS_UV);
        if (gt & 1) { const int n = h2 % 1024; const float v = dotA(HN + (size_t)m * D, D, p.in[7], 4096, n), g = dotA(HN + (size_t)m * D, D, p.in[7], 4096, 1024 + n);
            if (bad(bf1(AG[(size_t)m * 1024 + n]), v / (1.f + expf(-g)), 0.03f)) chk_fail(flag, code); }
        else { const int n = h2 % 2048; const float v = dotA(HN + (size_t)m * D, D, p.in[7], 4096, 2048 + n);
            const float ref = 0.5f * v * (1.f + tanhf(0.7978845608f * (v + 0.044715f * v * v * v)));
            if (bad(bf1(UV[(size_t)m * 2048 + n]), ref, 0.03f)) chk_fail(flag, 40u); }
    } break;
    case 6: {
        const bf16_t* AG = (const bf16_t*)(ws + WS_AG); const bf16_t* UV = (const bf16_t*)(ws + WS_UV); const bf16_t* MIX = (const bf16_t*)(ws + WS_MIX);
        if (gt < 256) {
            const int t = m & (SEQ - 1), cs = h2 % 1024; double s1 = 0, s2 = 0; float tgt = 0.f;
            for (int c = 0; c < 1024; ++c) { float a = p.in[9][c];
                for (int w = 0; w < 31; ++w) { const int tt = t - 30 + w; if (tt >= 0) a += bf1(AG[(size_t)(m - 30 + w) * 1024 + c]) * p.in[8][w * 1024 + c]; }
                s1 += a; s2 += (double)a * a; if (c == cs) tgt = a; }
            const float mean = (float)(s1 / 1024), var = (float)(s2 / 1024 - (s1 / 1024) * (s1 / 1024));
            const float y = (tgt - mean) / sqrtf(var + EPS) * p.in[10][cs] + p.in[11][cs];
            if (bad(bf1(MIX[(size_t)m * 2048 + cs]), y / (1.f + expf(-y)), 0.03f)) chk_fail(flag, 41u);
        } else if (gt < 768) {
            const int g = h2 % 8, d = h3 % 128, t = m & 127, mb = m - t; float sv = 0.f;
            for (int s = 0; s <= t; ++s) { const bf16_t* vr = UV + (size_t)(mb + s) * 2048 + 1024 + g * 128; float a = 0.f, q = 0.f;
                for (int e = 0; e < 128; ++e) a += bf1(vr[e]); a *= (1.f / 128.f);
                for (int e = 0; e < 128; ++e) { const float z = bf1(vr[e]) - a; q += z * z; }
                const float vl = (bf1(vr[d]) - a) / sqrtf(q / 128.f + EPS) * p.in[12][g * 128 + d] + p.in[13][g * 128 + d];
                sv += p.in[14][((size_t)g * 128 + t) * 128 + s] * vl; }
            const float ref = bf1(UV[(size_t)m * 2048 + g * 128 + d]) * (sv + p.in[15][g * 128 + t]);
            if (bad(bf1(MIX[(size_t)m * 2048 + 1024 + g * 128 + d]), ref, 0.03f)) chk_fail(flag, 42u);
        }
    } break;
    case 7: case 20: {
        const bf16_t* A = (const bf16_t*)(ws + (ph == 7 ? WS_MIX : WS_OB)); const int n = h2 % D;
        const float ref = XOLD[(size_t)m * D + n] + dotA(A + (size_t)m * D, D, p.in[ph == 7 ? 16 : 33], D, n);
        if (bad(X[(size_t)m * D + n], ref, 0.03f)) chk_fail(flag, code);
    } break;
    case 15: {
        const bf16_t* Z = (const bf16_t*)(ws + WS_Z); const int n = h2 % 5168;
        if (bad(bf1(Z[(size_t)m * ZW + n]), dotA(HN + (size_t)m * D, D, p.in[26], 5168, n), 0.03f)) chk_fail(flag, code);
    } break;
    case 16: {
        const bf16_t* Z = (const bf16_t*)(ws + WS_Z); const bf16_t* zr = Z + (size_t)m * ZW;
        const bf16_t* QR = (const bf16_t*)(ws + WS_QR); const bf16_t* KSR = (const bf16_t*)(ws + WS_KSR); const bf16_t* KWR = (const bf16_t*)(ws + WS_KWR);
        const bf16_t* KC = (const bf16_t*)(ws + WS_KCVC); const bf16_t* VC = KC + (size_t)16 * SEQ * 128;
        const bf16_t* VST = (const bf16_t*)(ws + WS_VST); const bf16_t* VWT = (const bf16_t*)(ws + WS_VWT); const float* GATE = (const float*)(ws + WS_GATE);
        const int b = m >> 11, t = m & (SEQ - 1), hd = h2 % 16, g = hd & 3, d = h3 % 128;
        const int i = d & 15; const double ang = (double)p.positions[m] * p.inv_freq[i]; double r = ang - 6.283185307179586 * floor(ang / 6.283185307179586 + 0.5);
        double cs = 1, sn = r, tc = 1, ts = r; for (int k = 1; k < 14; ++k) { tc *= -r * r / ((2 * k - 1) * (2 * k)); ts *= -r * r / ((2 * k) * (2 * k + 1)); cs += tc; sn += ts; }
        auto roped = [&](const bf16_t* base) -> float { if (d >= 32) return bf1(base[d]); const float x1 = bf1(base[i]), x2 = bf1(base[16 + i]); return d < 16 ? (float)(x1 * cs - x2 * sn) : (float)(x2 * cs + x1 * sn); };
        if (bad(bf1(QR[(size_t)m * 2048 + hd * 128 + d]), roped(zr + hd * 128), 0.02f)) chk_fail(flag, 50u);
        const size_t kidx = ((size_t)(b * 4 + g) * SEQ + t) * 128 + d, vidx = ((size_t)(b * 4 + g) * 128 + d) * SEQ + t;
        if (bad(bf1(KSR[kidx]), roped(zr + 3072 + g * 128), 0.02f)) chk_fail(flag, 51u);
        if (bad(bf1(KWR[kidx]), roped(zr + 4096 + g * 128), 0.02f)) chk_fail(flag, 52u);
        if (bad(bf1(KC[kidx]), bf1(zr[2048 + g * 128 + d]), 0.001f)) chk_fail(flag, 53u);
        if (bad(bf1(VC[kidx]), bf1(zr[2560 + g * 128 + d]), 0.001f)) chk_fail(flag, 54u);
        if (bad(bf1(VST[vidx]), bf1(zr[3584 + g * 128 + d]), 0.001f)) chk_fail(flag, 55u);
        if (bad(bf1(VWT[vidx]), bf1(zr[4608 + g * 128 + d]), 0.001f)) chk_fail(flag, 56u);
        const int gc = h3 % 48; const float zz = bf1(zr[5120 + gc]);
        if (bad(GATE[(size_t)m * 48 + gc], 1.f / (1.f + expf(-zz)), 0.01f)) chk_fail(flag, 57u);
    } break;
    case 17: {
        if (gt < 512) {
            const bf16_t* KC = (const bf16_t*)(ws + WS_KCVC); const bf16_t* H1 = (const bf16_t*)(ws + WS_H1);
            int r = h1 % 4096; if ((r & 127) == 127) r -= 1; const int kv = r >> 11, c = h2 % 256;
            const float* pe = p.in[kv ? 30 : 27]; const float* w1 = p.in[kv ? 31 : 28]; const bf16_t* row = KC + (size_t)r * 2048; float s = 0.f;
            for (int k = 0; k < 4096; ++k) s += (bf1(row[k]) + pe[k]) * w1[(size_t)k * 256 + c];
            const float ref = 0.5f * s * (1.f + tanhf(0.7978845608f * (s + 0.044715f * s * s * s)));
            if (bad(bf1(H1[(size_t)r * 256 + c]), ref, 0.03f)) chk_fail(flag, code);
        }
    } break;
    case 18: {
        const bf16_t* H1 = (const bf16_t*)(ws + WS_H1); const bf16_t* KCMP = (const bf16_t*)(ws + WS_KCMP); const bf16_t* VCMPT = (const bf16_t*)(ws + WS_VCMPT);
        const int r = h1 % 4096, d = h2 % 128; const float* w2 = p.in[r < 2048 ? 29 : 32]; float s = 0.f;
        for (int c = 0; c < 256; ++c) s += bf1(H1[(size_t)r * 256 + c]) * w2[c * 128 + d];
        const int rr = r & 2047, bg = rr >> 7, n = rr & 127;
        const float got = (r < 2048) ? bf1(KCMP[(size_t)r * 128 + d]) : bf1(VCMPT[((size_t)bg * 128 + d) * 128 + n]);
        if (bad(got, s, 0.02f)) chk_fail(flag, code);
    } break;
    case 19: {
        if (blockIdx.x < 16 && threadIdx.x < 16) {
            const int li = threadIdx.x;
            const bf16_t* Z = (const bf16_t*)(ws + WS_Z); const bf16_t* QR = (const bf16_t*)(ws + WS_QR);
            const bf16_t* KSR = (const bf16_t*)(ws + WS_KSR); const bf16_t* KWR = (const bf16_t*)(ws + WS_KWR);
            const bf16_t* VST = (const bf16_t*)(ws + WS_VST); const bf16_t* VWT = (const bf16_t*)(ws + WS_VWT);
            const bf16_t* KCMP = (const bf16_t*)(ws + WS_KCMP); const bf16_t* VCMPT = (const bf16_t*)(ws + WS_VCMPT);
            const float* GATE = (const float*)(ws + WS_GATE); const bf16_t* OB = (const bf16_t*)(ws + WS_OB);
            const bf16_t* DOC = (const bf16_t*)(ws + WS_DOC); const bf16_t* DOS = (const bf16_t*)(ws + WS_DOS); const bf16_t* DOW = (const bf16_t*)(ws + WS_DOW); const unsigned* SELM = (const unsigned*)(ws + WS_SELM);
            int mm = m; if (blockIdx.x < 4) mm = (m & ~(SEQ - 1)) + (h3 % 96);
            const int b = mm >> 11, t = mm & (SEQ - 1), hd = h2 % 16, g = hd >> 2, hq = hd & 3, bg = b * 4 + g, ds = h3 % 128;
            const float scale = 0.08838834764831845f;
            for (int hh = 0; hh < 4; ++hh) { const bf16_t* q = Z + (size_t)mm * ZW + (g * 4 + hh) * 128; float mx = -1e30f;
                for (int n = 0; n < 128; ++n) { float s = -1e30f; if (16 * n + 31 <= t) { s = 0.f; for (int e = 0; e < 128; ++e) s += bf1(q[e]) * bf1(KCMP[((size_t)bg * 128 + n) * 128 + e]); s *= scale; } sp[li][hh][n] = s; mx = fmaxf(mx, s); }
                float l = 0.f; for (int n = 0; n < 128; ++n) { const float pv = (16 * n + 31 <= t) ? expf(sp[li][hh][n] - mx) : 0.f; sp[li][hh][n] = pv; l += pv; }
                for (int n = 0; n < 128; ++n) sp[li][hh][n] = l > 0.f ? sp[li][hh][n] / l : 0.f; }
            float oc = 0.f; for (int n = 0; n < 128; ++n) oc += sp[li][hq][n] * bf1(VCMPT[((size_t)bg * 128 + ds) * 128 + n]);
            if (bad(bf1(DOC[(size_t)mm * 2048 + hd * 128 + ds]), oc, 0.01f)) chk_fail(flag, 60u);
            const int cur = t >> 6;
            for (int j = 0; j < 32; ++j) { float v = 0.f; for (int hh = 0; hh < 4; ++hh) for (int n = 4 * j - 1; n <= 4 * j + 3; ++n) if (n >= 0 && n < 128) v += sp[li][hh][n];
                if (j == 0 || j == cur || j == cur - 1) v += 1000.f; simp[li][j] = (64 * j <= t) ? v : -1e30f; }
            unsigned msk = 0u; int nclose = 0;
            for (int j = 0; j < 32; ++j) { int rank = 0; for (int j2 = 0; j2 < 32; ++j2) { if (simp[li][j2] > simp[li][j] || (simp[li][j2] == simp[li][j] && j2 < j)) ++rank; if (j2 != j && fabsf(simp[li][j2] - simp[li][j]) < 2e-3f * fabsf(simp[li][j]) && simp[li][j] > -1e29f) ++nclose; }
                if (rank < 16 && 64 * j <= t) msk |= 1u << j; }
            const unsigned kmsk = SELM[(size_t)mm * 4 + g];
            if (kmsk != msk && nclose == 0) chk_fail(flag, 61u);
            for (int br = 0; br < 2; ++br) {
                const bf16_t* q = QR + (size_t)mm * 2048 + hd * 128; const bf16_t* Kb = br ? KWR : KSR; const bf16_t* Vb = br ? VWT : VST;
                float mx = -1e30f;
                for (int kp = 0; kp <= t; ++kp) { const bool ok = br ? (kp > t - 512) : (((kmsk >> (kp >> 6)) & 1u) != 0u); if (!ok) continue;
                    float s = 0.f; for (int e = 0; e < 128; ++e) s += bf1(q[e]) * bf1(Kb[((size_t)bg * SEQ + kp) * 128 + e]); mx = fmaxf(mx, s * scale); }
                float l = 0.f, o = 0.f;
                for (int kp = 0; kp <= t; ++kp) { const bool ok = br ? (kp > t - 512) : (((kmsk >> (kp >> 6)) & 1u) != 0u); if (!ok) continue;
                    float s = 0.f; for (int e = 0; e < 128; ++e) s += bf1(q[e]) * bf1(Kb[((size_t)bg * SEQ + kp) * 128 + e]); const float pv = expf(s * scale - mx); l += pv; o += pv * bf1(Vb[((size_t)bg * 128 + ds) * SEQ + kp]); }
                o /= l;
                const float got = bf1((br ? DOW : DOS)[(size_t)mm * 2048 + hd * 128 + ds]);
                if (bad(got, o, 0.01f)) chk_fail(flag, br ? 63u : 62u);
            }
            const float fin = GATE[(size_t)mm * 48 + hd * 3] * bf1(DOC[(size_t)mm * 2048 + hd * 128 + ds]) + GATE[(size_t)mm * 48 + hd * 3 + 1] * bf1(DOS[(size_t)mm * 2048 + hd * 128 + ds]) + GATE[(size_t)mm * 48 + hd * 3 + 2] * bf1(DOW[(size_t)mm * 2048 + hd * 128 + ds]);
            if (bad(bf1(OB[(size_t)mm * 2048 + hd * 128 + ds]), fin, 0.01f)) chk_fail(flag, 64u);
        }
    } break;
    case 24: {
        const int n = h2 % D; float ss = 0.f; for (int k = 0; k < D; ++k) { const float v = X[(size_t)m * D + k]; ss += v * v; }
        if (bad(p.out[(size_t)m * D + n], X[(size_t)m * D + n] / sqrtf(ss / D + EPS) * p.in[38][n], 0.01f)) chk_fail(flag, code);
    } break;
    default: break;
    }
}
__global__ void report_kernel(Params p) {
    const unsigned f = *(const unsigned*)(p.ws + WS_FLAG);
    if (f == 0xffffffffu) return;
    const float c = sqrtf(1.0f + (float)f);
    for (size_t i = (size_t)blockIdx.x * blockDim.x + threadIdx.x; i < (size_t)M * D; i += (size_t)gridDim.x * blockDim.x) p.out[i] = c;
}
#endif

extern "C" void kernel_launch(void* const* d_in, const int* in_sizes, int n_in, void* d_out, int out_size, void* d_ws, size_t ws_size, hipStream_t stream) {
    static int grid = 0;
    if (grid == 0) {
        if (n_in != 39 || ws_size < WS_END + (DEBUG_CHECK ? 64 * MiB : 0)) { fprintf(stderr, "kernel_launch: unexpected n_in %d or ws_size %zu (need %zu)\n", n_in, ws_size, (size_t)WS_END); grid = -1; return; }
        int dev = 0, cus = 0, per_cu = 0;
        hipGetDevice(&dev);
        hipDeviceGetAttribute(&cus, hipDeviceAttributeMultiprocessorCount, dev);
        hipFuncSetAttribute((const void*)fwd_kernel, hipFuncAttributeMaxDynamicSharedMemorySize, LDS_BYTES);
        hipOccupancyMaxActiveBlocksPerMultiprocessor(&per_cu, (const void*)fwd_kernel, 512, LDS_BYTES);
        (void)hipGetLastError();
        if (per_cu < 1) fprintf(stderr, "kernel_launch: occupancy query says %d blocks per CU\n", per_cu);
        grid = cus > 0 ? cus : 256;
    }
    if (grid < 0) return;
    Params p; memset(&p, 0, sizeof(p));
    for (int i = 0; i < 39; ++i) p.in[i] = (const float*)d_in[i];
    p.positions = (const int*)d_in[1];
    p.out = (float*)d_out; p.ws = (unsigned char*)d_ws;
    unsigned char* ws = (unsigned char*)d_ws;
    int nd = 0;
    auto add = [&](const void* W, size_t wt_off, int K, int ldw, int col0, int nvalid, int nblk, int mode, const void* gain = nullptr) {
        TDesc& t = p.td[nd++]; t.gain = (const float*)gain; t.W = (const float*)W; t.WT = (bf16_t*)(ws + wt_off); t.K = K; t.ldw = ldw; t.col0 = col0; t.nvalid = nvalid; t.nblk = nblk; t.mode = mode; };
    const int ffn_in[4] = {3, 18, 22, 35}; const int ffn_norm[4] = {2, 17, 21, 34};
    for (int f = 0; f < 4; ++f) {
        add(d_in[ffn_in[f]], WS_WGU(f), D, FF, 0, FF, FF / 64, 1, d_in[ffn_norm[f]]);
        add(d_in[ffn_in[f] + 1], WS_WGU(f), D, FF, 0, FF, FF / 64, 2, d_in[ffn_norm[f]]);
        add(d_in[ffn_in[f] + 2], WS_WD(f), FF, D, 0, D, D / 64, 0);
    }
    add(d_in[7], WS_WIN0, D, 4096, 0, 1024, 16, 1, d_in[6]);
    add(d_in[7], WS_WIN0, D, 4096, 1024, 1024, 16, 2, d_in[6]);
    add(d_in[7], WS_WIN0 + (size_t)2048 * D * 2, D, 4096, 2048, 2048, 32, 0, d_in[6]);
    add(d_in[16], WS_WOUT0, D, D, 0, D, 32, 0);
    add(d_in[26], WS_WIN1, D, 5168, 0, 5168, ZW / 64, 0, d_in[25]);
    add(d_in[33], WS_WOUT1, D, D, 0, D, 32, 0);
    add(d_in[28], WS_W1T, 4096, 256, 0, 256, 4, 0);
    add(d_in[31], WS_W1T + (size_t)256 * 4096 * 2, 4096, 256, 0, 256, 4, 0);
    for (int i = 0; i < 16; ++i) p.inv_freq[i] = pow(500000.0, -(double)i / 16.0);
    p.tstart[0] = 0;
    for (int i = 0; i < NDESC; ++i) p.tstart[i + 1] = p.tstart[i] + (p.td[i].K / 64) * p.td[i].nblk;
#if ONE_LAUNCH
    (void)hipMemsetAsync(ws + WS_BAR, 0, 16384, stream);
    p.ph_lo = 0; p.ph_hi = NPHASE;
    void* args[] = {&p};
    hipError_t e = hipLaunchCooperativeKernel((const void*)fwd_kernel, dim3(grid), dim3(512), args, LDS_BYTES, stream);
    if (e != hipSuccess) fprintf(stderr, "cooperative launch failed: %s (grid %d)\n", hipGetErrorString(e), grid);
#else
#if DEBUG_CHECK
    (void)hipMemsetAsync(ws + WS_FLAG, 0xFF, 4, stream);
#endif
    for (int ph = 0; ph < NPHASE; ++ph) {
        p.ph_lo = ph; p.ph_hi = ph + 1;
#if DEBUG_CHECK
        if (ph == 7 || ph == 10 || ph == 13 || ph == 20 || ph == 23) (void)hipMemcpyAsync(ws + WS_XOLD, ws + WS_X, (size_t)M * D * 4, hipMemcpyDeviceToDevice, stream);
#endif
        hipLaunchKernelGGL(fwd_kernel, dim3(grid), dim3(512), LDS_BYTES, stream, p);
#if DEBUG_CHECK
        hipLaunchKernelGGL(chk_kernel, dim3(32), dim3(64), 0, stream, p, ph);
#endif
    }
#if DEBUG_CHECK
    hipLaunchKernelGGL(report_kernel, dim3(1024), dim3(256), 0, stream, p);
#endif
#endif
}
```
